# Optimizing an MI355X kernel written in HIP

```python
import math, functools
import jax, jax.numpy as jnp
from jax import lax
import numpy as np

D_MODEL = 4096
BATCH = 2
SEQ = 4096
DEPTH = 1
DEC_BATCH = 128
DEC_SEQ = 4
PAST_LEN = 8192
PAGE_SIZE = 128

N_META = 16
WINDOW = 128
ATTN_BLOCK = WINDOW
A_HEADS = D_MODEL // 128
A_KV_HEADS = A_HEADS // 4
A_GROUP = A_HEADS // A_KV_HEADS
A_HEAD_DIM = 64
ROT_DIM = A_HEAD_DIM // 4
ROPE_THETA = 500000.0
B_HEADS = D_MODEL // 256
B_HEAD_DIM = 128
CONV_W = 4
DELTA_CHUNK = 64
D_FF = 4 * D_MODEL
EPS = 1e-6

QA_DIM = A_HEADS * A_HEAD_DIM
KVA_DIM = A_KV_HEADS * A_HEAD_DIM
QB_DIM = B_HEADS * B_HEAD_DIM
CONV_DIM = 3 * QB_DIM
IN_SIZES = (QA_DIM, KVA_DIM, KVA_DIM, CONV_DIM, QB_DIM, B_HEADS, B_HEADS, D_MODEL, D_MODEL)
IN_DIM = QA_DIM + 2 * KVA_DIM + CONV_DIM + QB_DIM + 2 * B_HEADS + 2 * D_MODEL

kernel_name = 'hybrid_swa_sink_gated_deltanet_decoder_step'


def rmsnorm(x, w):
    xf = x.astype(jnp.float32)
    y = xf * lax.rsqrt(jnp.mean(xf * xf, axis=-1, keepdims=True) + EPS)
    return (y * w.astype(jnp.float32)).astype(x.dtype)


def l2norm(x):
    xf = x.astype(jnp.float32)
    return xf * lax.rsqrt(jnp.sum(xf * xf, axis=-1, keepdims=True) + EPS)


def partial_rope(x, pos):
    half = ROT_DIM // 2
    inv_freq = ROPE_THETA ** (-jnp.arange(half, dtype=jnp.float32) * (2.0 / ROT_DIM))
    ang = pos.astype(jnp.float32)[:, None] * inv_freq[None, :]
    cos = jnp.cos(ang)[:, None, :]
    sin = jnp.sin(ang)[:, None, :]
    xr = x[..., :ROT_DIM].astype(jnp.float32)
    x1, x2 = xr[..., :half], xr[..., half:]
    rot = jnp.concatenate([x1 * cos - x2 * sin, x2 * cos + x1 * sin], axis=-1)
    return jnp.concatenate([rot.astype(x.dtype), x[..., ROT_DIM:]], axis=-1)


def sink_probs(s, mask, sinks):
    sk = sinks.astype(jnp.float32).reshape(A_KV_HEADS, A_GROUP, 1, 1)
    s = jnp.where(mask, s, -jnp.inf)
    m = jnp.maximum(jnp.max(s, axis=-1, keepdims=True), sk)
    p = jnp.exp(s - m)
    return p / (jnp.sum(p, axis=-1, keepdims=True) + jnp.exp(sk - m))


def attend_prompt(q, k, v, sinks):
    Bn, L = q.shape[:2]
    nb = -(-L // ATTN_BLOCK)
    pad = nb * ATTN_BLOCK - L
    qb = jnp.pad(q, ((0, 0), (0, pad), (0, 0), (0, 0))).reshape(Bn, nb, ATTN_BLOCK, A_KV_HEADS, A_GROUP, A_HEAD_DIM)

    def band(x):
        xp = jnp.pad(x, ((0, 0), (ATTN_BLOCK, pad), (0, 0), (0, 0))).reshape(Bn, nb + 1, ATTN_BLOCK, A_KV_HEADS, A_HEAD_DIM)
        return jnp.concatenate([xp[:, :-1], xp[:, 1:]], axis=2)

    kb, vb = band(k), band(v)
    qpos = jnp.arange(nb)[:, None] * ATTN_BLOCK + jnp.arange(ATTN_BLOCK)[None, :]
    kpos = (jnp.arange(nb)[:, None] - 1) * ATTN_BLOCK + jnp.arange(2 * ATTN_BLOCK)[None, :]
    diff = qpos[:, :, None] - kpos[:, None, :]
    mask = (diff >= 0) & (diff <= WINDOW) & (kpos[:, None, :] >= 0)
    s = jnp.einsum('bnqhgd,bnkhd->bnhgqk', qb, kb, preferred_element_type=jnp.float32) * (A_HEAD_DIM ** -0.5)
    p = sink_probs(s, mask[None, :, None, None], sinks)
    o = jnp.einsum('bnhgqk,bnkhd->bnqhgd', p.astype(v.dtype), vb)
    o = o.reshape(Bn, nb * ATTN_BLOCK, QA_DIM)[:, :L]
    return o, k[:, -WINDOW:], v[:, -WINDOW:]


def attend_sample(q, k, v, sinks, cache_k, cache_v):
    Bd, T = q.shape[:2]
    n_buf = cache_k.shape[1]
    k_all = jnp.concatenate([cache_k.astype(k.dtype), k], axis=1)
    v_all = jnp.concatenate([cache_v.astype(v.dtype), v], axis=1)
    qpos = PAST_LEN + jnp.arange(T)
    kpos = PAST_LEN - n_buf + jnp.arange(n_buf + T)
    diff = qpos[:, None] - kpos[None, :]
    mask = (diff >= 0) & (diff <= WINDOW)
    qg = q.reshape(Bd, T, A_KV_HEADS, A_GROUP, A_HEAD_DIM)
    s = jnp.einsum('bqhgd,bkhd->bhgqk', qg, k_all, preferred_element_type=jnp.float32) * (A_HEAD_DIM ** -0.5)
    p = sink_probs(s, mask, sinks)
    o = jnp.einsum('bhgqk,bkhd->bqhgd', p.astype(v.dtype), v_all).reshape(Bd, T, QA_DIM)
    return o, k_all[:, -n_buf:], v_all[:, -n_buf:]


def short_conv(x, hist, w):
    T = x.shape[1]
    xx = jnp.concatenate([hist.astype(x.dtype), x], axis=1)
    y = xx[:, 0:T].astype(jnp.float32) * w[0].astype(jnp.float32)
    for j in range(1, CONV_W):
        y = y + xx[:, j:j + T].astype(jnp.float32) * w[j].astype(jnp.float32)
    return jax.nn.silu(y), xx[:, -(CONV_W - 1):]


def gated_delta_chunked(q, k, v, g, beta, s0, chunk):
    Bn, T, H, Dv = v.shape
    n = T // chunk

    def blk(x):
        return jnp.moveaxis(x.reshape((Bn, n, chunk) + x.shape[2:]), 2, 3)

    qc, kc, vc, gc, bc = blk(q), blk(k), blk(v), blk(g), blk(beta)
    G = jnp.cumsum(gc, axis=-1)
    tri = jnp.tril(jnp.ones((chunk, chunk), bool))
    tri_strict = jnp.tril(jnp.ones((chunk, chunk), bool), -1)
    decay = jnp.exp(jnp.where(tri, G[..., :, None] - G[..., None, :], -jnp.inf))
    kbeta = kc * bc[..., None]
    M = jnp.where(tri_strict, jnp.einsum('bnhid,bnhjd->bnhij', kbeta, kc) * decay, 0.0)
    eye = jnp.eye(chunk, dtype=jnp.float32)
    rhs = jnp.concatenate([vc * bc[..., None], kbeta * jnp.exp(G)[..., None]], axis=-1)
    sol = lax.linalg.triangular_solve(eye + M, rhs, left_side=True, lower=True, unit_diagonal=True)
    U, W = sol[..., :Dv], sol[..., Dv:]
    qk = jnp.einsum('bnhid,bnhjd->bnhij', qc, kc) * decay
    q_dec = qc * jnp.exp(G)[..., None]
    k_dec = kc * jnp.exp(G[..., -1:] - G)[..., None]
    g_last = jnp.exp(G[..., -1])

    def step(S, xs):
        U_i, W_i, qk_i, qd_i, kd_i, gl_i = xs
        v_new = U_i - jnp.einsum('bhcd,bhde->bhce', W_i, S)
        o = jnp.einsum('bhcd,bhde->bhce', qd_i, S) + jnp.einsum('bhij,bhje->bhie', qk_i, v_new)
        S = S * gl_i[..., None, None] + jnp.einsum('bhcd,bhce->bhde', kd_i, v_new)
        return S, o

    xs = tuple(jnp.moveaxis(a, 1, 0) for a in (U, W, qk, q_dec, k_dec, g_last))
    S, o = lax.scan(step, s0, xs)
    o = jnp.swapaxes(jnp.moveaxis(o, 0, 1), 2, 3).reshape(Bn, T, H, Dv)
    return o, S


def _project(hn, w_in):
    z = jnp.einsum('btd,dc->btc', hn, w_in)
    cuts, acc = [], 0
    for size in IN_SIZES[:-1]:
        acc += size
        cuts.append(acc)
    return jnp.split(z, cuts, axis=-1)


def _layer(h, pos, attend, conv_hist, s0, front_pad, chunk,
           norm_mix_pre, norm_mix_post, norm_mlp_pre, norm_mlp_post, w_in, sinks, conv_w,
           a_log, dt_bias, delta_norm, w_branch_a, w_branch_b, w_out, w_up, w_down):
    Bn, T, _ = h.shape
    hn = rmsnorm(h, norm_mix_pre)
    qa, ka, va, qkv_b, zb, b_raw, a_raw, ga, gb = _project(hn, w_in)
    qa = partial_rope(qa.reshape(Bn, T, A_HEADS, A_HEAD_DIM), pos)
    ka = partial_rope(ka.reshape(Bn, T, A_KV_HEADS, A_HEAD_DIM), pos)
    va = va.reshape(Bn, T, A_KV_HEADS, A_HEAD_DIM)
    oa, new_k, new_v = attend(qa, ka, va, sinks)
    xc, new_conv = short_conv(qkv_b, conv_hist, conv_w)
    qb, kb, vb = jnp.split(xc, [QB_DIM, 2 * QB_DIM], axis=-1)
    qb = l2norm(qb.reshape(Bn, T, B_HEADS, B_HEAD_DIM)) * (B_HEAD_DIM ** -0.5)
    kb = l2norm(kb.reshape(Bn, T, B_HEADS, B_HEAD_DIM))
    vb = vb.reshape(Bn, T, B_HEADS, B_HEAD_DIM)
    g = -jnp.exp(a_log.astype(jnp.float32)) * jax.nn.softplus(a_raw.astype(jnp.float32) + dt_bias.astype(jnp.float32))
    beta = jax.nn.sigmoid(b_raw.astype(jnp.float32))
    p4 = ((0, 0), (front_pad, 0), (0, 0), (0, 0))
    p3 = ((0, 0), (front_pad, 0), (0, 0))
    ob, s_new = gated_delta_chunked(jnp.pad(qb, p4), jnp.pad(kb, p4), jnp.pad(vb, p4),
                                    jnp.pad(g, p3), jnp.pad(beta, p3), s0.astype(jnp.float32), chunk)
    ob = ob[:, front_pad:]
    ob = rmsnorm(ob, delta_norm) * jax.nn.silu(zb.reshape(Bn, T, B_HEADS, B_HEAD_DIM).astype(jnp.float32))
    ob = ob.reshape(Bn, T, QB_DIM).astype(h.dtype)
    merged = jax.nn.sigmoid(ga) * (oa @ w_branch_a) + jax.nn.sigmoid(gb) * (ob @ w_branch_b)
    h = h + rmsnorm(merged @ w_out, norm_mix_post)
    u = jnp.square(jax.nn.relu(rmsnorm(h, norm_mlp_pre) @ w_up))
    h = h + rmsnorm(u @ w_down, norm_mlp_post)
    return h, new_k, new_v, new_conv, s_new.astype(s0.dtype)


def setup_inputs(seed: int = 0) -> dict:
    key = jax.random.key(seed)
    ks = jax.random.split(key, 24)
    f32 = jnp.float32

    def nrm(k, shape, scale):
        return jax.random.normal(k, shape, f32) * scale

    n_buf = min(WINDOW, PAST_LEN)
    dt = jnp.exp(jax.random.uniform(ks[20], (DEPTH, B_HEADS), f32, math.log(1e-3), math.log(1e-1)))
    return {
        'x_prompt': nrm(ks[0], (BATCH, SEQ, D_MODEL), 1.0),
        'x_sample': nrm(ks[1], (DEC_BATCH, DEC_SEQ, D_MODEL), 1.0),
        'cache_win_k': nrm(ks[2], (DEPTH, DEC_BATCH, n_buf, A_KV_HEADS, A_HEAD_DIM), 1.0),
        'cache_win_v': nrm(ks[3], (DEPTH, DEC_BATCH, n_buf, A_KV_HEADS, A_HEAD_DIM), 1.0),
        'state_conv': nrm(ks[4], (DEPTH, DEC_BATCH, CONV_W - 1, CONV_DIM), 1.0),
        'state_delta': nrm(ks[5], (DEPTH, DEC_BATCH, B_HEADS, B_HEAD_DIM, B_HEAD_DIM), 0.1),
        'meta_tokens': nrm(ks[6], (N_META, D_MODEL), 1.0),
        'norm_mix_pre': 1.0 + nrm(ks[7], (DEPTH, D_MODEL), 0.02),
        'norm_mix_post': 1.0 + nrm(ks[8], (DEPTH, D_MODEL), 0.02),
        'norm_mlp_pre': 1.0 + nrm(ks[9], (DEPTH, D_MODEL), 0.02),
        'norm_mlp_post': 1.0 + nrm(ks[10], (DEPTH, D_MODEL), 0.02),
        'w_in': nrm(ks[11], (DEPTH, D_MODEL, IN_DIM), D_MODEL ** -0.5),
        'sinks': nrm(ks[12], (DEPTH, A_HEADS), 0.5),
        'conv_w': nrm(ks[13], (DEPTH, CONV_W, CONV_DIM), CONV_W ** -0.5),
        'a_log': jnp.log(jax.random.uniform(ks[14], (DEPTH, B_HEADS), f32, 1.0, 16.0)),
        'dt_bias': dt + jnp.log(-jnp.expm1(-dt)),
        'delta_norm': 1.0 + nrm(ks[15], (DEPTH, B_HEAD_DIM), 0.02),
        'w_branch_a': nrm(ks[16], (DEPTH, QA_DIM, D_MODEL), QA_DIM ** -0.5),
        'w_branch_b': nrm(ks[17], (DEPTH, QB_DIM, D_MODEL), QB_DIM ** -0.5),
        'w_out': nrm(ks[18], (DEPTH, D_MODEL, D_MODEL), D_MODEL ** -0.5),
        'w_up': nrm(ks[19], (DEPTH, D_MODEL, D_FF), D_MODEL ** -0.5),
        'w_down': nrm(ks[21], (DEPTH, D_FF, D_MODEL), D_FF ** -0.5),
    }


def reference(x_prompt, x_sample, cache_win_k, cache_win_v, state_conv, state_delta, meta_tokens,
              norm_mix_pre, norm_mix_post, norm_mlp_pre, norm_mlp_post, w_in, sinks, conv_w,
              a_log, dt_bias, delta_norm, w_branch_a, w_branch_b, w_out, w_up, w_down):
    layer_w = (norm_mix_pre, norm_mix_post, norm_mlp_pre, norm_mlp_post, w_in, sinks, conv_w,
               a_log, dt_bias, delta_norm, w_branch_a, w_branch_b, w_out, w_up, w_down)
    Bn = x_prompt.shape[0]
    hp = jnp.concatenate([jnp.broadcast_to(meta_tokens.astype(x_prompt.dtype)[None], (Bn, N_META, D_MODEL)), x_prompt], axis=1)
    L = hp.shape[1]
    pos_p = jnp.arange(L)
    hs = x_sample
    pos_s = PAST_LEN + jnp.arange(hs.shape[1])
    front_pad = (-N_META) % DELTA_CHUNK
    pk, pv, pc, pd, sk, sv, sc, sd = [], [], [], [], [], [], [], []
    for l in range(DEPTH):
        wl = [w[l] for w in layer_w]
        conv0 = jnp.zeros((Bn, CONV_W - 1, CONV_DIM), hp.dtype)
        s0 = jnp.zeros((Bn, B_HEADS, B_HEAD_DIM, B_HEAD_DIM), hp.dtype)
        hp, k_p, v_p, c_p, d_p = _layer(hp, pos_p, attend_prompt, conv0, s0, front_pad, DELTA_CHUNK, *wl)
        att_s = functools.partial(attend_sample, cache_k=cache_win_k[l], cache_v=cache_win_v[l])
        hs, k_s, v_s, c_s, d_s = _layer(hs, pos_s, att_s, state_conv[l], state_delta[l], 0, hs.shape[1], *wl)
        pk.append(k_p); pv.append(v_p); pc.append(c_p); pd.append(d_p)
        sk.append(k_s); sv.append(v_s); sc.append(c_s); sd.append(d_s)
    return (hp[:, N_META:], hs,
            jnp.stack(pk), jnp.stack(pv), jnp.stack(pc), jnp.stack(pd),
            jnp.stack(sk), jnp.stack(sv), jnp.stack(sc), jnp.stack(sd))
```

```cpp
#include <hip/hip_runtime.h>
#include <cstdio>
#include <cstdint>
namespace pg8 {
#define PG8_LAS __attribute__((address_space(3)))
typedef unsigned short bf16_t;
typedef short bf16x8 __attribute__((ext_vector_type(8)));
typedef float f32x4 __attribute__((ext_vector_type(4)));
typedef unsigned u32x4 __attribute__((ext_vector_type(4)));
constexpr int BM = 256, BK = 64, HALF = 128, HTB = HALF * BK * 2  , STAGE_BYTES = 8 * HTB, NXCD = 8, WGM = 8;

__host__ __device__ __forceinline__ int lds_byte(int r, int c) { const int st = (r >> 4) * 2 + (c >> 5), rr = r & 15, cc = c & 31, ob = rr * 64 + cc * 2; return st * 1024 + (ob ^ (((ob >> 9) & 1) << 5)); }
__host__ __device__ __forceinline__ void stage_rc(int b, int& R, int& C) { const int st = b / 1024, sb = b % 1024, swz = sb ^ (((sb >> 9) & 1) << 5); R = (st >> 1) * 16 + swz / 64; C = (st & 1) * 32 + (swz % 64) / 2; }
__host__ __device__ __forceinline__ int perm32(int rho) { const int n = rho >> 4, i = rho & 15; return 8 * (i >> 2) + 4 * n + (i & 3); }

struct Unit { int pm, pn; };
struct Gemm { const bf16_t* A; const bf16_t* Bt; int M, N, K; };

struct StaticOrder {
    int nM, nN, nwg, G, c;
    __host__ __device__ void init(int M, int N, int G_, int c_) { nM = M / BM; nN = N / BM; nwg = nM * nN; G = G_; c = c_; }
    __host__ __device__ bool next(int i, Unit& u) const {
        const long L = (long)i * G + c; if (L >= nwg) return false;
        int wgid = (int)L; { const int q = nwg / NXCD, r = nwg % NXCD, xcd = wgid % NXCD, off = wgid / NXCD; wgid = (xcd < r ? xcd * (q + 1) : r * (q + 1) + (xcd - r) * q) + off; }
        const int nig = WGM * nN, gid = wgid / nig, fm = gid * WGM, gsz = (nM - fm) < WGM ? (nM - fm) : WGM;
        u.pm = fm + ((wgid % nig) % gsz); u.pn = (wgid % nig) / gsz; return true;
    }
    __device__ __forceinline__ void a_ready(const Unit&) const {}
    __device__ __forceinline__ void done(const Unit&) const {}
};

typedef float f32x2_t __attribute__((ext_vector_type(2))); typedef __bf16 bf16x2_t __attribute__((ext_vector_type(2)));
__device__ __forceinline__ unsigned cvt_pk_bf16(float lo, float hi) { f32x2_t v = {lo, hi}; bf16x2_t b = __builtin_convertvector(v, bf16x2_t); return __builtin_bit_cast(unsigned, b); }
__device__ __forceinline__ float bf_lo(unsigned w) { return __uint_as_float(w << 16); }
__device__ __forceinline__ float bf_hi(unsigned w) { return __uint_as_float(w & 0xffff0000u); }
__device__ __forceinline__ float sigmoidf_(float x) { return __builtin_amdgcn_rcpf(1.0f + __expf(-x)); }

struct EpiZ {
    static constexpr bool PERM = true, AFTER_DRAIN = false;
    bf16_t* Z; int ldz; int nrows; int zcols; float* AB;
    __device__ __forceinline__ void operator()(const f32x4 (&acc)[2][2][4][2], const Unit& u, int wr, int wc, int fr, int fq) const {
        const int row0 = u.pm * BM + wr * 64 + fr; const int colt = u.pn * BM;
        if (colt >= zcols) {
            if (wc == 0) {
#pragma unroll
                for (int ai = 0; ai < 2; ++ai)
#pragma unroll
                    for (int m = 0; m < 4; ++m) { const int row = row0 + ai * HALF + m * 16;
                        if (row < nrows) { float* p = AB + (size_t)row * 32 + 8 * fq; *(f32x4*)p = acc[ai][0][m][0]; *(f32x4*)(p + 4) = acc[ai][0][m][1]; } }
            }
            return;
        }
        const int col0 = colt + wc * 32 + 8 * fq;
#pragma unroll
        for (int ai = 0; ai < 2; ++ai)
#pragma unroll
            for (int m = 0; m < 4; ++m) { const int row = row0 + ai * HALF + m * 16;
                if (row < nrows) { bf16_t* rowp = Z + (size_t)row * ldz + col0;
#pragma unroll
                    for (int bj = 0; bj < 2; ++bj) { const f32x4 v0 = acc[ai][bj][m][0], v1 = acc[ai][bj][m][1];
                        u32x4 w; w.x = cvt_pk_bf16(v0[0], v0[1]); w.y = cvt_pk_bf16(v0[2], v0[3]); w.z = cvt_pk_bf16(v1[0], v1[1]); w.w = cvt_pk_bf16(v1[2], v1[3]);
                        *(u32x4*)(rowp + bj * HALF) = w; } } }
    }
};
struct EpiGateF32 {
    static constexpr bool PERM = true, AFTER_DRAIN = false;
    float* T1; int ldc; const bf16_t* G; int ldg;
    __device__ __forceinline__ void operator()(const f32x4 (&acc)[2][2][4][2], const Unit& u, int wr, int wc, int fr, int fq) const {
        const int row0 = u.pm * BM + wr * 64 + fr; const int col0 = u.pn * BM + wc * 32 + 8 * fq;
#pragma unroll
        for (int ai = 0; ai < 2; ++ai)
#pragma unroll
            for (int m = 0; m < 4; ++m) { const int row = row0 + ai * HALF + m * 16;
#pragma unroll
                for (int bj = 0; bj < 2; ++bj) { const u32x4 g = *(const u32x4*)(G + (size_t)row * ldg + col0 + bj * HALF);
                    const f32x4 v0 = acc[ai][bj][m][0], v1 = acc[ai][bj][m][1]; f32x4 o0, o1;
                    o0[0] = v0[0] * sigmoidf_(bf_lo(g.x)); o0[1] = v0[1] * sigmoidf_(bf_hi(g.x)); o0[2] = v0[2] * sigmoidf_(bf_lo(g.y)); o0[3] = v0[3] * sigmoidf_(bf_hi(g.y));
                    o1[0] = v1[0] * sigmoidf_(bf_lo(g.z)); o1[1] = v1[1] * sigmoidf_(bf_hi(g.z)); o1[2] = v1[2] * sigmoidf_(bf_lo(g.w)); o1[3] = v1[3] * sigmoidf_(bf_hi(g.w));
                    float* p = T1 + (size_t)row * ldc + col0 + bj * HALF; *(f32x4*)p = o0; *(f32x4*)(p + 4) = o1; } }
    }
};
struct EpiGateAddBf16 {
    static constexpr bool PERM = true, AFTER_DRAIN = false;
    bf16_t* O; const float* T1; int ldc; const bf16_t* G; int ldg;
    __device__ __forceinline__ void operator()(const f32x4 (&acc)[2][2][4][2], const Unit& u, int wr, int wc, int fr, int fq) const {
        const int row0 = u.pm * BM + wr * 64 + fr; const int col0 = u.pn * BM + wc * 32 + 8 * fq;
#pragma unroll
        for (int ai = 0; ai < 2; ++ai)
#pragma unroll
            for (int m = 0; m < 4; ++m) { const int row = row0 + ai * HALF + m * 16;
#pragma unroll
                for (int bj = 0; bj < 2; ++bj) { const u32x4 g = *(const u32x4*)(G + (size_t)row * ldg + col0 + bj * HALF);
                    const float* tp = T1 + (size_t)row * ldc + col0 + bj * HALF; const f32x4 t0 = *(const f32x4*)tp, t1 = *(const f32x4*)(tp + 4);
                    const f32x4 v0 = acc[ai][bj][m][0], v1 = acc[ai][bj][m][1]; f32x4 o0, o1;
                    o0[0] = t0[0] + v0[0] * sigmoidf_(bf_lo(g.x)); o0[1] = t0[1] + v0[1] * sigmoidf_(bf_hi(g.x)); o0[2] = t0[2] + v0[2] * sigmoidf_(bf_lo(g.y)); o0[3] = t0[3] + v0[3] * sigmoidf_(bf_hi(g.y));
                    o1[0] = t1[0] + v1[0] * sigmoidf_(bf_lo(g.z)); o1[1] = t1[1] + v1[1] * sigmoidf_(bf_hi(g.z)); o1[2] = t1[2] + v1[2] * sigmoidf_(bf_lo(g.w)); o1[3] = t1[3] + v1[3] * sigmoidf_(bf_hi(g.w));
                    u32x4 w; w.x = cvt_pk_bf16(o0[0], o0[1]); w.y = cvt_pk_bf16(o0[2], o0[3]); w.z = cvt_pk_bf16(o1[0], o1[1]); w.w = cvt_pk_bf16(o1[2], o1[3]);
                    *(u32x4*)(O + (size_t)row * ldc + col0 + bj * HALF) = w; } }
    }
};
struct EpiRawSq {
    static constexpr bool PERM = false, AFTER_DRAIN = false;
    float* C; int ldc; float* SQ; int ldsq;
    __device__ __forceinline__ void operator()(const f32x4 (&acc)[2][2][4][2], const Unit& u, int wr, int wc, int fr, int fq) const {
        const int row0 = u.pm * BM + wr * 64 + fr; const int col0 = u.pn * BM + wc * 32 + 4 * fq;
#pragma unroll
        for (int ai = 0; ai < 2; ++ai)
#pragma unroll
            for (int m = 0; m < 4; ++m) { const int row = row0 + ai * HALF + m * 16; float* p = C + (size_t)row * ldc + col0; float s = 0.f;
#pragma unroll
                for (int bj = 0; bj < 2; ++bj)
#pragma unroll
                    for (int n = 0; n < 2; ++n) { const f32x4 v = acc[ai][bj][m][n]; *(f32x4*)(p + bj * HALF + n * 16) = v; s += (v[0] * v[0] + v[1] * v[1]) + (v[2] * v[2] + v[3] * v[3]); }
                s += __shfl_xor(s, 16); s += __shfl_xor(s, 32);
                if (fq == 0) SQ[(size_t)row * ldsq + 4 * u.pn + wc] = s; }
    }
};
struct EpiRelu2 {
    static constexpr bool PERM = true, AFTER_DRAIN = false;
    bf16_t* O; int ldc;
    __device__ __forceinline__ void operator()(const f32x4 (&acc)[2][2][4][2], const Unit& u, int wr, int wc, int fr, int fq) const {
        const int row0 = u.pm * BM + wr * 64 + fr; const int col0 = u.pn * BM + wc * 32 + 8 * fq;
#pragma unroll
        for (int ai = 0; ai < 2; ++ai)
#pragma unroll
            for (int m = 0; m < 4; ++m) { bf16_t* rowp = O + (size_t)(row0 + ai * HALF + m * 16) * ldc + col0;
#pragma unroll
                for (int bj = 0; bj < 2; ++bj) { f32x4 v0 = acc[ai][bj][m][0], v1 = acc[ai][bj][m][1];
#pragma unroll
                    for (int e = 0; e < 4; ++e) { const float a = fmaxf(v0[e], 0.f), b = fmaxf(v1[e], 0.f); v0[e] = a * a; v1[e] = b * b; }
                    u32x4 w; w.x = cvt_pk_bf16(v0[0], v0[1]); w.y = cvt_pk_bf16(v0[2], v0[3]); w.z = cvt_pk_bf16(v1[0], v1[1]); w.w = cvt_pk_bf16(v1[2], v1[3]);
                    *(u32x4*)(rowp + bj * HALF) = w; } }
    }
};

template <class Epi, class Sched, bool ALIGN_EPI = false, bool SP2 = false>
__device__ __forceinline__ void gemm_phase(PG8_LAS unsigned char* lds, const Gemm g, const Sched& S, const Epi& E) {
    const int tid = threadIdx.x, wid = __builtin_amdgcn_readfirstlane(tid >> 6), lane = tid & 63, wr = wid >> 2, wc = wid & 3, fr = lane & 15, fq = lane >> 4;
    const int K = g.K, nt = K / BK;
    unsigned voffA[2], voffB[2];
#pragma unroll
    for (int i = 0; i < 2; ++i) { int R, C; stage_rc(tid * 16 + i * 8192, R, C); const int Rb = Epi::PERM ? ((R & ~31) + perm32(R & 31)) : R;
        voffA[i] = (unsigned)(R * K + C) * 2u; voffB[i] = (unsigned)(Rb * K + C) * 2u; }
    const size_t kstep = (size_t)(BK * 2);
    const size_t hstep = (size_t)HALF * K * 2;
    const size_t tstep = 2 * hstep;
    const unsigned ldsw = (unsigned)wid * 1024u;
    const int aoff = lds_byte(wr * 64 + fr, fq * 8), boff = lds_byte(wc * 32 + fr, fq * 8);
#define PG8_SA(b, h) (((b) * 2 + (h)) * HTB)
#define PG8_SB(b, h) ((4 + (b) * 2 + (h)) * HTB)
#define PG8_STAGE(bufoff, gbase, voff) do { _Pragma("unroll") for (int _i = 0; _i < 2; ++_i) \
        __builtin_amdgcn_global_load_lds((const unsigned*)((const char*)(gbase) + (voff)[_i]), (PG8_LAS unsigned*)(lds + (bufoff) + ldsw + _i * 8192), 16, 0, 0); } while (0)
#define PG8_LDA(dst, b, h) do { _Pragma("unroll") for (int m = 0; m < 4; ++m) _Pragma("unroll") for (int k = 0; k < 2; ++k) dst[m][k] = *(const PG8_LAS bf16x8*)(lds + PG8_SA(b, h) + aoff + m * 2048 + k * 1024); } while (0)
#define PG8_LDB(dst, b, h) do { _Pragma("unroll") for (int n = 0; n < 2; ++n) _Pragma("unroll") for (int k = 0; k < 2; ++k) dst[n][k] = *(const PG8_LAS bf16x8*)(lds + PG8_SB(b, h) + boff + n * 2048 + k * 1024); } while (0)
#define PG8_MMA(ai, bj, At, Bt) do { __builtin_amdgcn_s_setprio(1); _Pragma("unroll") for (int m = 0; m < 4; ++m) _Pragma("unroll") for (int n = 0; n < 2; ++n) _Pragma("unroll") for (int k = 0; k < 2; ++k) \
        acc[ai][bj][m][n] = __builtin_amdgcn_mfma_f32_16x16x32_bf16(Bt[n][k], At[m][k], acc[ai][bj][m][n], 0, 0, 0); __builtin_amdgcn_s_setprio(0); } while (0)
#define PG8_WAIT_V(n) asm volatile("s_waitcnt vmcnt(" #n ")" ::: "memory")
#define PG8_WAIT_L(n) asm volatile("s_waitcnt lgkmcnt(" #n ")" ::: "memory")
#define PG8_BAR __builtin_amdgcn_s_barrier()
#define PG8_SCHED __builtin_amdgcn_sched_barrier(0)
    Unit cur, nxt; int ui = 0;
    if (!S.next(0, cur)) return;
    f32x4 acc[2][2][4][2];
#pragma unroll
    for (int a = 0; a < 2; ++a)
#pragma unroll
        for (int b = 0; b < 2; ++b)
#pragma unroll
            for (int m = 0; m < 4; ++m)
#pragma unroll
                for (int n = 0; n < 2; ++n) acc[a][b][m][n] = (f32x4){0.f, 0.f, 0.f, 0.f};
    bf16x8 At[4][2], B0[2][2], B1[2][2];
    const char* cA = (const char*)g.A + (size_t)cur.pm * tstep; const char* cB = (const char*)g.Bt + (size_t)cur.pn * tstep;
    S.a_ready(cur);
    if constexpr (SP2) {
        PG8_STAGE(PG8_SB(0, 0), cB, voffB); PG8_STAGE(PG8_SB(0, 1), cB + hstep, voffB); PG8_STAGE(PG8_SA(0, 0), cA, voffA); PG8_STAGE(PG8_SA(0, 1), cA + hstep, voffA);
        if (wr == 1) PG8_BAR;
        PG8_WAIT_V(2); PG8_BAR;
        PG8_STAGE(PG8_SB(1, 0), cB + kstep, voffB); PG8_STAGE(PG8_SA(1, 0), cA + kstep, voffA); PG8_STAGE(PG8_SB(1, 1), cB + hstep + kstep, voffB);
        PG8_WAIT_V(6); PG8_BAR;
    } else {
        PG8_STAGE(PG8_SB(0, 0), cB, voffB); PG8_STAGE(PG8_SA(0, 0), cA, voffA); PG8_STAGE(PG8_SB(0, 1), cB + hstep, voffB); PG8_STAGE(PG8_SA(0, 1), cA + hstep, voffA);
        if (wr == 1) PG8_BAR;
        PG8_WAIT_V(4); PG8_BAR;
        PG8_STAGE(PG8_SB(1, 0), cB + kstep, voffB); PG8_STAGE(PG8_SA(1, 0), cA + kstep, voffA); PG8_STAGE(PG8_SB(1, 1), cB + hstep + kstep, voffB);
        PG8_WAIT_V(6); PG8_BAR;
    }
    for (;;) {
        const bool has_next = S.next(ui + 1, nxt);
        const char* nA = has_next ? (const char*)g.A + (size_t)nxt.pm * tstep : cA; const char* nB = has_next ? (const char*)g.Bt + (size_t)nxt.pn * tstep : cB;
        for (int t = 0; t < nt; t += 2) {
            const bool last = (t == nt - 2);
            const char* a1 = cA + (size_t)(t + 1) * kstep;
            const char* a2 = last ? nA : cA + (size_t)(t + 2) * kstep; const char* b2 = last ? nB : cB + (size_t)(t + 2) * kstep;
            const char* a3 = a2 + kstep; const char* b3 = b2 + kstep;
            if (last && has_next) S.a_ready(nxt);
            if constexpr (SP2) {
            PG8_LDB(B0, 0, 0); PG8_LDB(B1, 0, 1); PG8_SCHED; PG8_LDA(At, 0, 0); PG8_STAGE(PG8_SA(1, 1), a1 + hstep, voffA);
            PG8_WAIT_V(8); PG8_WAIT_L(0); PG8_BAR; PG8_MMA(0, 0, At, B0); PG8_MMA(0, 1, At, B1); PG8_BAR; PG8_SCHED;
            PG8_LDA(At, 0, 1); PG8_STAGE(PG8_SB(0, 0), b2, voffB); PG8_STAGE(PG8_SB(0, 1), b2 + hstep, voffB); PG8_STAGE(PG8_SA(0, 0), a2, voffA);
            PG8_WAIT_V(8); PG8_WAIT_L(0); PG8_BAR; PG8_MMA(1, 0, At, B0); PG8_MMA(1, 1, At, B1); PG8_BAR; PG8_SCHED;
            PG8_LDB(B0, 1, 0); PG8_LDB(B1, 1, 1); PG8_SCHED; PG8_LDA(At, 1, 0); PG8_STAGE(PG8_SA(0, 1), a2 + hstep, voffA);
            PG8_WAIT_V(8); PG8_WAIT_L(0); PG8_BAR; PG8_MMA(0, 0, At, B0); PG8_MMA(0, 1, At, B1); PG8_BAR; PG8_SCHED;
            PG8_LDA(At, 1, 1); PG8_STAGE(PG8_SB(1, 0), b3, voffB); PG8_STAGE(PG8_SB(1, 1), b3 + hstep, voffB); PG8_STAGE(PG8_SA(1, 0), a3, voffA);
            PG8_WAIT_V(8); PG8_WAIT_L(0); PG8_BAR; PG8_MMA(1, 0, At, B0); PG8_MMA(1, 1, At, B1); PG8_BAR; PG8_SCHED;
            } else {
            PG8_LDB(B0, 0, 0); PG8_SCHED; PG8_LDA(At, 0, 0); PG8_STAGE(PG8_SA(1, 1), a1 + hstep, voffA);
            PG8_WAIT_L(8); PG8_BAR; PG8_WAIT_L(0); PG8_MMA(0, 0, At, B0); PG8_BAR; PG8_SCHED;
            PG8_LDB(B1, 0, 1); PG8_STAGE(PG8_SB(0, 0), b2, voffB);
            PG8_BAR; PG8_WAIT_L(0); PG8_MMA(0, 1, At, B1); PG8_BAR;
            PG8_LDA(At, 0, 1); PG8_STAGE(PG8_SA(0, 0), a2, voffA);
            PG8_BAR; PG8_WAIT_L(0); PG8_MMA(1, 0, At, B0); PG8_BAR; PG8_SCHED;
            PG8_STAGE(PG8_SB(0, 1), b2 + hstep, voffB);
            PG8_WAIT_V(6); PG8_BAR; PG8_MMA(1, 1, At, B1); PG8_BAR;
            PG8_LDB(B0, 1, 0); PG8_SCHED; PG8_LDA(At, 1, 0); PG8_STAGE(PG8_SA(0, 1), a2 + hstep, voffA);
            PG8_WAIT_L(8); PG8_BAR; PG8_WAIT_L(0); PG8_MMA(0, 0, At, B0); PG8_BAR; PG8_SCHED;
            PG8_LDB(B1, 1, 1); PG8_STAGE(PG8_SB(1, 0), b3, voffB);
            PG8_BAR; PG8_WAIT_L(0); PG8_MMA(0, 1, At, B1); PG8_BAR;
            PG8_LDA(At, 1, 1); PG8_STAGE(PG8_SA(1, 0), a3, voffA);
            PG8_BAR; PG8_WAIT_L(0); PG8_MMA(1, 0, At, B0); PG8_BAR; PG8_SCHED;
            PG8_STAGE(PG8_SB(1, 1), b3 + hstep, voffB);
            PG8_WAIT_V(6); PG8_BAR; PG8_MMA(1, 1, At, B1); PG8_BAR;
            }
        }
        if constexpr (ALIGN_EPI) { if (wr == 0) PG8_BAR; }
        if constexpr (!Epi::AFTER_DRAIN) { E(acc, cur, wr, wc, fr, fq); S.done(cur); }
        if (!has_next) break;
#pragma unroll
        for (int a = 0; a < 2; ++a)
#pragma unroll
            for (int b = 0; b < 2; ++b)
#pragma unroll
                for (int m = 0; m < 4; ++m)
#pragma unroll
                    for (int n = 0; n < 2; ++n) acc[a][b][m][n] = (f32x4){0.f, 0.f, 0.f, 0.f};
        cur = nxt; cA = nA; cB = nB; ++ui;
        if constexpr (ALIGN_EPI) { if (wr == 1) PG8_BAR; }
    }
    PG8_WAIT_V(0);
    if constexpr (!ALIGN_EPI) { if (wr == 0) PG8_BAR; }
    PG8_BAR;
    if constexpr (Epi::AFTER_DRAIN) { E.fused(acc, cur, wr, wc, fr, fq, lds, wid, lane); S.done(cur); }
#undef PG8_SA
#undef PG8_SB
#undef PG8_STAGE
#undef PG8_LDA
#undef PG8_LDB
#undef PG8_MMA
#undef PG8_WAIT_V
#undef PG8_WAIT_L
#undef PG8_BAR
#undef PG8_SCHED
}
}
constexpr int NWAVES = 8, NTHR = 512;
constexpr int DM = 4096, DFF = 16384;
constexpr int PB = 2, PSEQ = 4096, NMETA = 16, PLEN = PSEQ + NMETA;
constexpr int SB = 128, ST = 4, PAST = 8192;
constexpr int MP = PB * PSEQ, MS = SB * ST, MM = MP + MS;
constexpr int META0 = MM, MVALID = MM + NMETA, MPAD = 8960;
constexpr int AH = 32, AKV = 8, AHD = 64, WIN = 128;
constexpr int BH = 16, BHD = 128, QB = 2048, CONVD = 6144;
constexpr int NIN_SRC = 19488, NINP = 19712, ZLD = 19456;
constexpr int ZC_QA = 0, ZC_KA = 2048, ZC_VA = 2560, ZC_QKVB = 3072, ZC_ZB = 9216, ZC_GA = 11264, ZC_GB = 15360;
constexpr float EPS = 1e-6f;
constexpr int NCH = 65, NUNIT_DN = PB * BH * NCH;
constexpr int NPOS = PLEN + ST;

constexpr size_t O_YP = 0, O_YS = O_YP + (size_t)MP * DM, O_WKP = O_YS + (size_t)MS * DM, O_WVP = O_WKP + (size_t)PB * WIN * 512, O_CP = O_WVP + (size_t)PB * WIN * 512,
                 O_DP = O_CP + (size_t)PB * 3 * CONVD, O_WKS = O_DP + (size_t)PB * BH * BHD * BHD, O_WVS = O_WKS + (size_t)SB * WIN * 512, O_CS = O_WVS + (size_t)SB * WIN * 512,
                 O_DS = O_CS + (size_t)SB * 3 * CONVD, O_END = O_DS + (size_t)SB * BH * BHD * BHD;
static_assert(O_END == 89165824, "d_out size");

constexpr size_t MiB = 1u << 20;
constexpr size_t WS_CTL = 0, CTL_ZERO_BYTES = 1 * MiB;
constexpr size_t WS_AB = 1 * MiB, WS_ROPE = 3 * MiB, WS_SQ1 = 4 * MiB, WS_SQ2 = 7 * MiB;
constexpr size_t WS_WA = 12 * MiB, WS_WB = 28 * MiB, WS_WOUT = 44 * MiB, WS_WUP = 76 * MiB, WS_WDN = 204 * MiB;
constexpr size_t WS_XN = 332 * MiB, WS_MERGED = WS_XN, WS_OA = 402 * MiB, WS_OB = 436 * MiB;
constexpr size_t WS_Z = 470 * MiB, WS_UACT = WS_Z;
constexpr size_t WS_WIN = 794 * MiB, WS_DN = WS_WIN, WS_RAW = WS_WIN, WS_END = 1084 * MiB;
constexpr size_t DN_AC = WS_DN, DN_BC = DN_AC + (size_t)NUNIT_DN * 32768, DN_QE = DN_BC + (size_t)NUNIT_DN * 32768, DN_OL = DN_QE + (size_t)NUNIT_DN * 16384, DN_ST = DN_OL + (size_t)NUNIT_DN * 16384;
static_assert(DN_ST + (size_t)NUNIT_DN * 32768 <= WS_END, "DeltaNet intermediates");
static_assert(WS_Z + (size_t)MVALID * ZLD * 2 <= WS_WIN && WS_UACT + (size_t)MM * DFF * 2 <= WS_WIN, "Z / UACT");
static_assert(WS_WIN + (size_t)NINP * DM * 2 <= WS_END && WS_RAW + (size_t)MM * DM * 4 <= WS_END, "W_IN_T / RAW");
static_assert(WS_XN + (size_t)MPAD * DM * 2 <= WS_OA && WS_OA + (size_t)MM * QB * 2 <= WS_OB && WS_OB + (size_t)MM * QB * 2 <= WS_Z, "XN / OA / OB");
constexpr int CW_TMO = 0, CW_CODE = 1, CW_BAR = 4096;

constexpr int RING_OFF = 0, RING_BYTES = 131072;
constexpr int LDSCTL_OFF = 150528, MISC_OFF = LDSCTL_OFF + 320;
constexpr int LDS_BYTES = 151552;
static_assert(MISC_OFF + 128 <= LDS_BYTES, "LDS map");

#define GAS __attribute__((address_space(1)))
#define LAS __attribute__((address_space(3)))
#define DI __device__ __forceinline__
typedef unsigned short bf16;
typedef unsigned v4u __attribute__((ext_vector_type(4)));
typedef unsigned v2u __attribute__((ext_vector_type(2)));
typedef float f32x4 __attribute__((ext_vector_type(4)));
typedef float f32x16 __attribute__((ext_vector_type(16)));
typedef short bf16x8 __attribute__((ext_vector_type(8)));
typedef short s16x4 __attribute__((ext_vector_type(4)));
typedef GAS unsigned gu32;
#define RLX_AGENT __ATOMIC_RELAXED, __HIP_MEMORY_SCOPE_AGENT
#define LDS_WAIT() asm volatile("s_waitcnt lgkmcnt(0)" ::: "memory")
#define VM_WAIT() asm volatile("s_waitcnt vmcnt(0)" ::: "memory")
DI unsigned f2bf(float f) { unsigned u = __builtin_bit_cast(unsigned, f); return (u + 0x7fffu + ((u >> 16) & 1u)) >> 16; }
DI unsigned pk2(float lo, float hi) { return pg8::cvt_pk_bf16(lo, hi); }
DI float bf2f(bf16 b) { return __uint_as_float((unsigned)b << 16); }
DI float bflo(unsigned w) { return __uint_as_float(w << 16); }
DI float bfhi(unsigned w) { return __uint_as_float(w & 0xffff0000u); }
DI float sigm(float x) { return __builtin_amdgcn_rcpf(1.0f + __expf(-x)); }
DI float siluf(float x) { return x * sigm(x); }
DI float wave_sum(float v) {
#pragma unroll
    for (int o = 1; o < 64; o <<= 1) v += __shfl_xor(v, o);
    return v;
}
#define XB_TMO      128
#define XB_XCNT(j)  (256  + 64 * (j))
#define XB_XSUB(j)  (1280 + 64 * (j))
#define XB_XGEN(j)  (2304 + 64 * (j))
#define XB_TOP      3328
#define XB_TOPGEN   3392
#define XCD_BAR_WORDS 3456
#define XB_SPIN_CAP (1u << 18)

__device__ __forceinline__ unsigned xb_ld(unsigned* p)              { return __hip_atomic_load(p, __ATOMIC_RELAXED, __HIP_MEMORY_SCOPE_AGENT); }
__device__ __forceinline__ unsigned xb_add(unsigned* p, unsigned v) { return __hip_atomic_fetch_add(p, v, __ATOMIC_RELAXED, __HIP_MEMORY_SCOPE_AGENT); }
__device__ __forceinline__ unsigned xb_xcc_id() { return (unsigned)__builtin_amdgcn_s_getreg((3 << 11) | 20) & 0xFu; }
#define XB_SPIN(cond, bar) do { unsigned _sp = 0; while (cond) { __builtin_amdgcn_s_sleep(1); \
    if ((++_sp & 255u) == 0u) { if (xb_ld(&(bar)[XB_TMO])) break; if (_sp > XB_SPIN_CAP) { atomicAdd(&(bar)[XB_TMO], 1u); break; } } } } while (0)

struct XcdBarrier {
    unsigned* bar; unsigned x;
    volatile LAS unsigned* st;
};

__device__ __forceinline__ XcdBarrier xcd_barrier_post(unsigned* bar, volatile LAS unsigned* st) {
    XcdBarrier b; b.bar = bar; b.x = xb_xcc_id(); b.st = st;
    if (threadIdx.x == 0) (void)xb_add(&bar[XB_XCNT(b.x)], 1u);
    return b;
}
__device__ __forceinline__ void xcd_barrier_complete(unsigned* bar, unsigned x, unsigned& nloc, unsigned& nx) {
    const unsigned G = gridDim.x * gridDim.y * gridDim.z;
    unsigned sum, cnt, mine, sp = 0u;
    for (;;) {
        sum = 0u; cnt = 0u; mine = 0u;
#pragma unroll
        for (unsigned j = 0; j < 16; ++j) { const unsigned c = xb_ld(&bar[XB_XCNT(j)]); sum += c; cnt += (c > 0u) ? 1u : 0u; mine = (j == x) ? c : mine; }
        if (sum == G) break;
        __builtin_amdgcn_s_sleep(1);
        if ((++sp & 255u) == 0u) { if (xb_ld(&bar[XB_TMO])) break; if (sp > XB_SPIN_CAP) { atomicAdd(&bar[XB_TMO], 1u); break; } }
    }
    nloc = mine > 0u ? mine : 1u; nx = cnt > 0u ? cnt : 1u;
}

__device__ __forceinline__ void xcd_barrier(const XcdBarrier& b) {
    asm volatile("s_waitcnt vmcnt(0)" ::: "memory");
    __syncthreads();
    if (threadIdx.x == 0) {
        unsigned* bar = b.bar;
        __builtin_amdgcn_s_waitcnt(0);
        unsigned nloc = b.st[0], nx = b.st[1];
        if (nloc == 0u) { xcd_barrier_complete(bar, b.x, nloc, nx); b.st[0] = nloc; b.st[1] = nx; }
        const unsigned old = xb_add(&bar[XB_XSUB(b.x)], 1u);
        const unsigned gen = old / nloc;
        if (old + 1u == (gen + 1u) * nloc) {
            __builtin_amdgcn_fence(__ATOMIC_RELEASE, "agent");
            asm volatile("s_waitcnt vmcnt(0)" ::: "memory");
            const unsigned og = xb_add(&bar[XB_TOP], 1u);
            const unsigned tg = og / nx;
            if (og + 1u == (tg + 1u) * nx) xb_add(&bar[XB_TOPGEN], 1u);
            else XB_SPIN(xb_ld(&bar[XB_TOPGEN]) == tg, bar);
            __builtin_amdgcn_fence(__ATOMIC_ACQUIRE, "agent");
            xb_add(&bar[XB_XGEN(b.x)], 1u);
            asm volatile("s_waitcnt vmcnt(0)" ::: "memory");
        } else {
            XB_SPIN(xb_ld(&bar[XB_XGEN(b.x)]) == gen, bar);
            __builtin_amdgcn_fence(__ATOMIC_ACQUIRE, "agent");
            asm volatile("s_waitcnt vmcnt(0)" ::: "memory");
        }
    }
    __syncthreads();
}

struct Args { const float* in[22]; float* out; unsigned char* ws; int ph_lo, ph_hi; };
enum { I_XP = 0, I_XS, I_CK, I_CV, I_SCONV, I_SDELTA, I_META, I_NMIXPRE, I_NMIXPOST, I_NMLPPRE, I_NMLPPOST, I_WIN, I_SINKS, I_CONVW, I_ALOG, I_DTB, I_DNORM, I_WA, I_WB, I_WOUT, I_WUP, I_WDN };

DI void p0_transpose_item(const float* W, int K, int ldn, bf16* WT, int k0, int n0, int drow, LAS float* scr, int lane) {
#pragma unroll 8
    for (int i = 0; i < 32; ++i) { const int kk = 2 * i + (lane >> 5); scr[kk * 33 + (lane & 31)] = W[(size_t)(k0 + kk) * ldn + n0 + (lane & 31)]; }
    LDS_WAIT(); asm volatile("" ::: "memory");
    const int c = lane & 7;
#pragma unroll
    for (int j = 0; j < 4; ++j) { const int n = (lane >> 3) + 8 * j; const LAS float* s = scr + (8 * c) * 33 + n;
        v4u o; o.x = pk2(s[0 * 33], s[1 * 33]); o.y = pk2(s[2 * 33], s[3 * 33]); o.z = pk2(s[4 * 33], s[5 * 33]); o.w = pk2(s[6 * 33], s[7 * 33]);
        *(GAS v4u*)(WT + (size_t)(drow + n) * K + k0 + 8 * c) = o; }
    LDS_WAIT(); asm volatile("" ::: "memory");
}
DI void rms_row_to_bf16(const float* xrow, const float* w, bf16* orow, int lane) {
    const GAS f32x4* xr = (const GAS f32x4*)xrow + lane; const GAS f32x4* wr = (const GAS f32x4*)w + lane;
    f32x4 v[16]; float s = 0.f;
#pragma unroll
    for (int j = 0; j < 16; ++j) { v[j] = xr[64 * j]; s += (v[j].x * v[j].x + v[j].y * v[j].y) + (v[j].z * v[j].z + v[j].w * v[j].w); }
    const float rstd = 1.f / sqrtf(wave_sum(s) * (1.f / DM) + EPS);
    GAS v2u* o8 = (GAS v2u*)orow + lane;
#pragma unroll
    for (int j = 0; j < 16; ++j) { const f32x4 g = wr[64 * j]; v2u o; o.x = pk2(v[j].x * rstd * g.x, v[j].y * rstd * g.y); o.y = pk2(v[j].z * rstd * g.z, v[j].w * rstd * g.w); o8[64 * j] = o; }
}
DI const float* h_row(const Args& a, int m) {
    return m < MP ? a.in[I_XP] + (size_t)m * DM : (m < MM ? a.in[I_XS] + (size_t)(m - MP) * DM : a.in[I_META] + (size_t)(m - MM) * DM);
}
DI void p0_prologue(const Args& a, LAS unsigned char* lds, int wave, int lane) {
    LAS float* scr = (LAS float*)(lds + wave * 16384);
    const int gw = blockIdx.x * NWAVES + wave, NGW = gridDim.x * NWAVES;
    unsigned char* ws = a.ws;
    constexpr int I_IN = (DM / 64) * (NIN_SRC / 32), I_A = (QB / 64) * (DM / 32), I_O = (DM / 64) * (DM / 32), I_U = (DM / 64) * (DFF / 32), I_D = (DFF / 64) * (DM / 32);
    constexpr int NITEMS = I_IN + 2 * I_A + I_O + I_U + I_D;
    for (int it = gw; it < NITEMS; it += NGW) {
        int r = it;
        if (r < I_IN) { const int nblk = NIN_SRC / 32, kb = r / nblk, nb = r % nblk, n0 = 32 * nb; const int drow = n0 < 11264 ? n0 : (n0 == 11264 ? ZLD : n0 - 32);
            p0_transpose_item(a.in[I_WIN], DM, NIN_SRC, (bf16*)(ws + WS_WIN), 64 * kb, n0, drow, scr, lane); continue; } r -= I_IN;
        if (r < I_A) { const int nblk = DM / 32; p0_transpose_item(a.in[I_WA], QB, DM, (bf16*)(ws + WS_WA), 64 * (r / nblk), 32 * (r % nblk), 32 * (r % nblk), scr, lane); continue; } r -= I_A;
        if (r < I_A) { const int nblk = DM / 32; p0_transpose_item(a.in[I_WB], QB, DM, (bf16*)(ws + WS_WB), 64 * (r / nblk), 32 * (r % nblk), 32 * (r % nblk), scr, lane); continue; } r -= I_A;
        if (r < I_O) { const int nblk = DM / 32; p0_transpose_item(a.in[I_WOUT], DM, DM, (bf16*)(ws + WS_WOUT), 64 * (r / nblk), 32 * (r % nblk), 32 * (r % nblk), scr, lane); continue; } r -= I_O;
        if (r < I_U) { const int nblk = DFF / 32; p0_transpose_item(a.in[I_WUP], DM, DFF, (bf16*)(ws + WS_WUP), 64 * (r / nblk), 32 * (r % nblk), 32 * (r % nblk), scr, lane); continue; } r -= I_U;
        { const int nblk = DM / 32; p0_transpose_item(a.in[I_WDN], DFF, DM, (bf16*)(ws + WS_WDN), 64 * (r / nblk), 32 * (r % nblk), 32 * (r % nblk), scr, lane); }
    }
    bf16* XN = (bf16*)(ws + WS_XN);
    for (int m = gw; m < MPAD; m += NGW) {
        if (m < MVALID) rms_row_to_bf16(h_row(a, m), a.in[I_NMIXPRE], XN + (size_t)m * DM, lane);
        else { GAS v4u* o = (GAS v4u*)(XN + (size_t)m * DM) + lane;
#pragma unroll
            for (int j = 0; j < 8; ++j) o[64 * j] = (v4u){0u, 0u, 0u, 0u}; }
    }
    float* rope = (float*)(ws + WS_ROPE);
    for (int e = blockIdx.x * NTHR + threadIdx.x; e < NPOS * 8; e += gridDim.x * NTHR) {
        const int pi = e >> 3, i = e & 7; const float pos = (float)(pi < PLEN ? pi : PAST + (pi - PLEN));
        const float inv = powf(500000.0f, -(float)i * 0.125f); const float ang = pos * inv; float sn, cs; sincosf(ang, &sn, &cs);
        rope[2 * e] = cs; rope[2 * e + 1] = sn;
    }
}

DI float rope_k(const bf16* zrow, const float* rope, int pi, int h, int d) {
    const bf16* kp = zrow + ZC_KA + h * AHD;
    if (d >= 16) return bf2f(kp[d]);
    const int i = d & 7; const float x1 = bf2f(kp[i]), x2 = bf2f(kp[8 + i]); const float cs = rope[(pi * 8 + i) * 2], sn = rope[(pi * 8 + i) * 2 + 1];
    return d < 8 ? x1 * cs - x2 * sn : x2 * cs + x1 * sn;
}
DI void p2_state_outputs(const Args& a) {
    const bf16* Z = (const bf16*)(a.ws + WS_Z); const float* rope = (const float*)(a.ws + WS_ROPE); float* out = a.out;
    const int gt = blockIdx.x * NTHR + threadIdx.x, NT = gridDim.x * NTHR;
    for (int e = gt; e < PB * WIN * 512; e += NT) {
        const int d = e & 63, h = (e >> 6) & 7, j = (e >> 9) & 127, b = e >> 16; const int t = PSEQ - WIN + j; const bf16* zr = Z + (size_t)(b * PSEQ + t) * ZLD;
        out[O_WKP + e] = rope_k(zr, rope, t + NMETA, h, d); out[O_WVP + e] = bf2f(zr[ZC_VA + h * AHD + d]);
    }
    for (int e = gt; e < PB * 3 * CONVD; e += NT) {
        const int c = e % CONVD, j = (e / CONVD) % 3, b = e / (3 * CONVD); out[O_CP + e] = bf2f(Z[(size_t)(b * PSEQ + PSEQ - 3 + j) * ZLD + ZC_QKVB + c]);
    }
    for (int e = gt; e < SB * WIN * 512; e += NT) {
        const int d = e & 63, h = (e >> 6) & 7, j = (e >> 9) & 127, b = e >> 16;
        if (j < WIN - ST) { const size_t src = ((size_t)b * WIN + j + ST) * 512 + h * 64 + d; out[O_WKS + e] = a.in[I_CK][src]; out[O_WVS + e] = a.in[I_CV][src]; }
        else { const int t = j - (WIN - ST); const bf16* zr = Z + (size_t)(MP + b * ST + t) * ZLD; out[O_WKS + e] = rope_k(zr, rope, PLEN + t, h, d); out[O_WVS + e] = bf2f(zr[ZC_VA + h * AHD + d]); }
    }
    for (int e = gt; e < SB * 3 * CONVD; e += NT) {
        const int c = e % CONVD, j = (e / CONVD) % 3, b = e / (3 * CONVD); out[O_CS + e] = bf2f(Z[(size_t)(MP + b * ST + 1 + j) * ZLD + ZC_QKVB + c]);
    }
}

#define MFMA16(a, b, c) __builtin_amdgcn_mfma_f32_16x16x32_bf16((a), (b), (c), 0, 0, 0)
#define MFMA32(a, b, c) __builtin_amdgcn_mfma_f32_32x32x16_bf16((a), (b), (c), 0, 0, 0)
DI int crow(int r, int hi) { return (r & 3) + 8 * (r >> 2) + 4 * hi; }
DI bf16x8 pack8(float a0, float a1, float a2, float a3, float a4, float a5, float a6, float a7) {
    v4u p; p.x = pk2(a0, a1); p.y = pk2(a2, a3); p.z = pk2(a4, a5); p.w = pk2(a6, a7); return __builtin_bit_cast(bf16x8, p);
}
template <int KS> DI f32x4 mm_lds(const LAS bf16* X, int ldx, int xrow0, const LAS bf16* Y, int ldy, int yrow0, int r, int q) {
    f32x4 acc = {0.f, 0.f, 0.f, 0.f};
    const LAS bf16* xp = X + (xrow0 + r) * ldx + 8 * q; const LAS bf16* yp = Y + (yrow0 + r) * ldy + 8 * q;
#pragma unroll
    for (int ks = 0; ks < KS; ++ks) { const bf16x8 xa = *(const LAS bf16x8*)(xp + 32 * ks); const bf16x8 yb = *(const LAS bf16x8*)(yp + 32 * ks); acc = MFMA16(xa, yb, acc); }
    return acc;
}

constexpr int AT_KS = 0, AT_VT = 27648, AT_KP = 72, AT_VP = 200;
constexpr int N_ATT_P = PB * AKV * (PSEQ / 64);
DI int zrow_of(int b, int tk) { return tk >= 0 ? b * PSEQ + tk : MVALID + tk; }
DI void attn_prompt_unit(const Args& a, LAS unsigned char* lds, int unit, int tid, int wave, int lane) {
    const bf16* Z = (const bf16*)(a.ws + WS_Z); const float* rope = (const float*)(a.ws + WS_ROPE); bf16* OA = (bf16*)(a.ws + WS_OA);
    const int qb = unit & 63, kvh = (unit >> 6) & 7, b = unit >> 9; const int t0 = qb * 64;
    LAS bf16* Ks = (LAS bf16*)(lds + AT_KS); LAS bf16* Vt = (LAS bf16*)(lds + AT_VT);
    for (int task = tid; task < 192 * 4; task += NTHR) {
        const int j = task >> 2, cp = task & 3; const int tk = t0 - 128 + j; v4u lo = {0u, 0u, 0u, 0u}, hi4 = {0u, 0u, 0u, 0u};
        if (tk >= -NMETA) { const bf16* src = Z + (size_t)zrow_of(b, tk) * ZLD + ZC_KA + kvh * AHD + 16 * cp; lo = *(const GAS v4u*)src; hi4 = *(const GAS v4u*)(src + 8);
            if (cp == 0) { const float* rp = rope + (size_t)(tk + NMETA) * 16; float x1[8], x2[8], o1[8], o2[8];
                x1[0] = bflo(lo.x); x1[1] = bfhi(lo.x); x1[2] = bflo(lo.y); x1[3] = bfhi(lo.y); x1[4] = bflo(lo.z); x1[5] = bfhi(lo.z); x1[6] = bflo(lo.w); x1[7] = bfhi(lo.w);
                x2[0] = bflo(hi4.x); x2[1] = bfhi(hi4.x); x2[2] = bflo(hi4.y); x2[3] = bfhi(hi4.y); x2[4] = bflo(hi4.z); x2[5] = bfhi(hi4.z); x2[6] = bflo(hi4.w); x2[7] = bfhi(hi4.w);
#pragma unroll
                for (int i = 0; i < 8; ++i) { const float cs = rp[2 * i], sn = rp[2 * i + 1]; o1[i] = x1[i] * cs - x2[i] * sn; o2[i] = x2[i] * cs + x1[i] * sn; }
                lo.x = pk2(o1[0], o1[1]); lo.y = pk2(o1[2], o1[3]); lo.z = pk2(o1[4], o1[5]); lo.w = pk2(o1[6], o1[7]);
                hi4.x = pk2(o2[0], o2[1]); hi4.y = pk2(o2[2], o2[3]); hi4.z = pk2(o2[4], o2[5]); hi4.w = pk2(o2[6], o2[7]); } }
        *(LAS v4u*)(Ks + j * AT_KP + 16 * cp) = lo; *(LAS v4u*)(Ks + j * AT_KP + 16 * cp + 8) = hi4;
    }
    for (int task = tid; task < 192 * 8; task += NTHR) {
        const int j = task >> 3, c8 = task & 7; const int tk = t0 - 128 + j; v4u v = {0u, 0u, 0u, 0u};
        if (tk >= -NMETA) v = *(const GAS v4u*)(Z + (size_t)zrow_of(b, tk) * ZLD + ZC_VA + kvh * AHD + 8 * c8);
        LAS bf16* vp = Vt + (8 * c8) * AT_VP + j;
        vp[0 * AT_VP] = (bf16)(v.x & 0xffffu); vp[1 * AT_VP] = (bf16)(v.x >> 16); vp[2 * AT_VP] = (bf16)(v.y & 0xffffu); vp[3 * AT_VP] = (bf16)(v.y >> 16);
        vp[4 * AT_VP] = (bf16)(v.z & 0xffffu); vp[5 * AT_VP] = (bf16)(v.z >> 16); vp[6 * AT_VP] = (bf16)(v.w & 0xffffu); vp[7 * AT_VP] = (bf16)(v.w >> 16);
    }
    const int r32 = lane & 31, hi = lane >> 5; const int g = wave >> 1, wq = wave & 1; const int hq = kvh * 4 + g; const int tq = t0 + 32 * wq + r32;
    const bf16* qsrc = Z + (size_t)(b * PSEQ + tq) * ZLD + ZC_QA + hq * AHD;
    bf16x8 qf[4];
    { const v4u lo = *(const GAS v4u*)qsrc, h4 = *(const GAS v4u*)(qsrc + 8); const float* rp = rope + (size_t)(tq + NMETA) * 16; float x1[8], x2[8], o[8];
      x1[0] = bflo(lo.x); x1[1] = bfhi(lo.x); x1[2] = bflo(lo.y); x1[3] = bfhi(lo.y); x1[4] = bflo(lo.z); x1[5] = bfhi(lo.z); x1[6] = bflo(lo.w); x1[7] = bfhi(lo.w);
      x2[0] = bflo(h4.x); x2[1] = bfhi(h4.x); x2[2] = bflo(h4.y); x2[3] = bfhi(h4.y); x2[4] = bflo(h4.z); x2[5] = bfhi(h4.z); x2[6] = bflo(h4.w); x2[7] = bfhi(h4.w);
#pragma unroll
      for (int i = 0; i < 8; ++i) { const float cs = rp[2 * i], sn = rp[2 * i + 1]; o[i] = hi == 0 ? x1[i] * cs - x2[i] * sn : x2[i] * cs + x1[i] * sn; }
      qf[0] = pack8(o[0], o[1], o[2], o[3], o[4], o[5], o[6], o[7]); }
#pragma unroll
    for (int ks = 1; ks < 4; ++ks) qf[ks] = __builtin_bit_cast(bf16x8, *(const GAS v4u*)(qsrc + 16 * ks + 8 * hi));
    LDS_WAIT(); __syncthreads();
    f32x16 s[5];
#pragma unroll
    for (int kb = 0; kb < 5; ++kb) { f32x16 acc = {};
        const LAS bf16* kp = Ks + (32 * (wq + kb) + r32) * AT_KP + 8 * hi;
#pragma unroll
        for (int ks = 0; ks < 4; ++ks) { const bf16x8 kf = *(const LAS bf16x8*)(kp + 16 * ks); acc = MFMA32(kf, qf[ks], acc); }
        s[kb] = acc; }
    const float C2 = 0.125f * 1.4426950408889634f; const float sink2 = a.in[I_SINKS][hq] * 1.4426950408889634f;
    float mx = sink2;
#pragma unroll
    for (int kb = 0; kb < 5; ++kb)
#pragma unroll
        for (int r = 0; r < 16; ++r) { const int jp = 32 * kb + crow(r, hi); const int tk = t0 - 128 + 32 * wq + jp;
            const bool ok = (jp >= r32) && (jp <= 128 + r32) && (tk >= -NMETA); const float v = ok ? s[kb][r] * C2 : -INFINITY; s[kb][r] = v; mx = fmaxf(mx, v); }
    mx = fmaxf(mx, __shfl_xor(mx, 32));
    float l = 0.f;
#pragma unroll
    for (int kb = 0; kb < 5; ++kb)
#pragma unroll
        for (int r = 0; r < 16; ++r) { const float p = exp2f(s[kb][r] - mx); s[kb][r] = p; l += p; }
    l += __shfl_xor(l, 32); l += exp2f(sink2 - mx);
    const float rl = 1.0f / l;
    f32x16 o[2]; o[0] = (f32x16){}; o[1] = (f32x16){};
#pragma unroll
    for (int kb = 0; kb < 5; ++kb)
#pragma unroll
        for (int st = 0; st < 2; ++st) {
            const bf16x8 pf = pack8(s[kb][8 * st + 0], s[kb][8 * st + 1], s[kb][8 * st + 2], s[kb][8 * st + 3], s[kb][8 * st + 4], s[kb][8 * st + 5], s[kb][8 * st + 6], s[kb][8 * st + 7]);
#pragma unroll
            for (int db = 0; db < 2; ++db) { const LAS bf16* vp = Vt + (32 * db + r32) * AT_VP + 32 * (wq + kb) + 16 * st + 4 * hi;
                const s16x4 v0 = *(const LAS s16x4*)vp, v1 = *(const LAS s16x4*)(vp + 8);
                const bf16x8 vf = __builtin_shufflevector(v0, v1, 0, 1, 2, 3, 4, 5, 6, 7);
                o[db] = MFMA32(vf, pf, o[db]); } }
    bf16* orow = OA + (size_t)(b * PSEQ + tq) * QB + hq * AHD;
#pragma unroll
    for (int db = 0; db < 2; ++db)
#pragma unroll
        for (int g4 = 0; g4 < 4; ++g4) { v2u w; w.x = pk2(o[db][4 * g4] * rl, o[db][4 * g4 + 1] * rl); w.y = pk2(o[db][4 * g4 + 2] * rl, o[db][4 * g4 + 3] * rl);
            *(GAS v2u*)(orow + 32 * db + 8 * g4 + 4 * hi) = w; }
    __syncthreads();
}

constexpr int AS_K = 0, AS_V = 34320, AS_Q = 68640, AS_P = 72736;
constexpr int N_ATT_S = SB * AKV;
DI void attn_sample_unit(const Args& a, LAS unsigned char* lds, int unit, int tid, int wave, int lane) {
    const bf16* Z = (const bf16*)(a.ws + WS_Z); const float* rope = (const float*)(a.ws + WS_ROPE); bf16* OA = (bf16*)(a.ws + WS_OA);
    const int kvh = unit & 7, b = unit >> 3;
    LAS float* Kf = (LAS float*)(lds + AS_K); LAS float* Vf = (LAS float*)(lds + AS_V); LAS float* Qf = (LAS float*)(lds + AS_Q); LAS float* Pf = (LAS float*)(lds + AS_P);
    for (int e = tid; e < 128 * 64; e += NTHR) { const int k = e >> 6, d = e & 63; const size_t src = ((size_t)b * WIN + k) * 512 + kvh * 64 + d; Kf[k * 65 + d] = a.in[I_CK][src]; Vf[k * 65 + d] = a.in[I_CV][src]; }
    if (tid < 256) { const int t = tid >> 6, d = tid & 63; const bf16* zr = Z + (size_t)(MP + b * ST + t) * ZLD; Kf[(128 + t) * 65 + d] = rope_k(zr, rope, PLEN + t, kvh, d); Vf[(128 + t) * 65 + d] = bf2f(zr[ZC_VA + kvh * AHD + d]); }
    for (int e = tid; e < 16 * 64; e += NTHR) { const int rr = e >> 6, d = e & 63; const int t = rr >> 2, g = rr & 3; const bf16* qp = Z + (size_t)(MP + b * ST + t) * ZLD + ZC_QA + (kvh * 4 + g) * AHD; float v;
        if (d >= 16) v = bf2f(qp[d]); else { const int i = d & 7; const float x1 = bf2f(qp[i]), x2 = bf2f(qp[8 + i]); const float cs = rope[((PLEN + t) * 8 + i) * 2], sn = rope[((PLEN + t) * 8 + i) * 2 + 1]; v = d < 8 ? x1 * cs - x2 * sn : x2 * cs + x1 * sn; }
        Qf[rr * 64 + d] = v; }
    LDS_WAIT(); __syncthreads();
    for (int p = tid; p < 16 * 132; p += NTHR) { const int rr = p / 132, k = p % 132; const int t = rr >> 2; float acc = 0.f;
#pragma unroll 16
        for (int d = 0; d < 64; ++d) acc += Qf[rr * 64 + d] * Kf[k * 65 + d];
        const bool ok = k < 128 ? (k >= t) : (k - 128 <= t); Pf[rr * 132 + k] = ok ? acc * 0.125f : -INFINITY; }
    LDS_WAIT(); __syncthreads();
#pragma unroll
    for (int i = 0; i < 2; ++i) { const int rr = wave * 2 + i; const int g = rr & 3; const float sk = a.in[I_SINKS][kvh * 4 + g];
        float v0 = Pf[rr * 132 + lane], v1 = Pf[rr * 132 + 64 + lane], v2 = lane < 4 ? Pf[rr * 132 + 128 + lane] : -INFINITY;
        float m = fmaxf(fmaxf(v0, v1), fmaxf(v2, sk));
#pragma unroll
        for (int o = 1; o < 64; o <<= 1) m = fmaxf(m, __shfl_xor(m, o));
        const float p0 = __expf(v0 - m), p1 = __expf(v1 - m), p2 = lane < 4 ? __expf(v2 - m) : 0.f; const float l = wave_sum(p0 + p1 + p2) + __expf(sk - m); const float rl = 1.0f / l;
        Pf[rr * 132 + lane] = p0 * rl; Pf[rr * 132 + 64 + lane] = p1 * rl; if (lane < 4) Pf[rr * 132 + 128 + lane] = p2 * rl; }
    LDS_WAIT(); __syncthreads();
    for (int e = tid; e < 16 * 64; e += NTHR) { const int rr = e >> 6, d = e & 63; const int t = rr >> 2, g = rr & 3; float acc = 0.f;
#pragma unroll 4
        for (int k = 0; k < 132; ++k) acc += Pf[rr * 132 + k] * Vf[k * 65 + d];
        OA[(size_t)(MP + b * ST + t) * QB + (kvh * 4 + g) * AHD + d] = (bf16)f2bf(acc); }
    LDS_WAIT(); __syncthreads();
}

DI float softplusf_(float x) { return x > 20.f ? x : log1pf(__expf(x)); }
constexpr int N_DN_S = SB * BH;
DI void dn_sample_unit(const Args& a, LAS unsigned char* lds, int unit, int tid, int wave, int lane) {
    const bf16* Z = (const bf16*)(a.ws + WS_Z); const float* AB = (const float*)(a.ws + WS_AB); bf16* OB = (bf16*)(a.ws + WS_OB);
    const int h = unit & 15, b = unit >> 4;
    LAS float* raw = (LAS float*)lds; LAS float* red = (LAS float*)(lds + 6144); LAS float* os = (LAS float*)(lds + 10240); LAS float* gb = (LAS float*)(lds + 12288);
    if (tid < 384) { const int which = tid >> 7, dd = tid & 127; const int c = which * QB + h * BHD + dd; float xx[7];
#pragma unroll
        for (int j = 0; j < 3; ++j) xx[j] = a.in[I_SCONV][((size_t)b * 3 + j) * CONVD + c];
#pragma unroll
        for (int t = 0; t < 4; ++t) xx[3 + t] = bf2f(Z[(size_t)(MP + b * ST + t) * ZLD + ZC_QKVB + c]);
        float w[4];
#pragma unroll
        for (int j = 0; j < 4; ++j) w[j] = a.in[I_CONVW][(size_t)j * CONVD + c];
#pragma unroll
        for (int t = 0; t < 4; ++t) { const float y = xx[t] * w[0] + xx[t + 1] * w[1] + xx[t + 2] * w[2] + xx[t + 3] * w[3]; raw[(which * 4 + t) * 128 + dd] = siluf(y); }
    } else if (tid < 388) { const int t = tid - 384; const int row = MP + b * ST + t; const float braw = AB[(size_t)row * 32 + h], araw = AB[(size_t)row * 32 + 16 + h];
        gb[t] = __expf(-__expf(a.in[I_ALOG][h]) * softplusf_(araw + a.in[I_DTB][h])); gb[4 + t] = sigm(braw); }
    LDS_WAIT(); __syncthreads();
    { const int which = wave >> 2, t = wave & 3; LAS float* v = raw + (which * 4 + t) * 128; const float x0 = v[lane], x1 = v[64 + lane]; const float ss = wave_sum(x0 * x0 + x1 * x1);
      const float sc = (1.0f / sqrtf(ss + EPS)) * (which == 0 ? 0.08838834764831845f : 1.0f); v[lane] = x0 * sc; v[64 + lane] = x1 * sc; }
    const int e = tid & 127, dg = tid >> 7;
    float S[32];
    const float* sp = a.in[I_SDELTA] + ((size_t)unit * BHD + 32 * dg) * BHD + e;
#pragma unroll
    for (int i = 0; i < 32; ++i) S[i] = sp[(size_t)i * BHD];
    LDS_WAIT(); __syncthreads();
    const LAS float* qs = raw; const LAS float* ks = raw + 512; const LAS float* vs = raw + 1024;
#pragma unroll
    for (int t = 0; t < 4; ++t) {
        const float eg = gb[t], beta = gb[4 + t]; float part = 0.f;
#pragma unroll
        for (int i = 0; i < 32; ++i) part += ks[t * 128 + 32 * dg + i] * S[i];
        red[dg * 128 + e] = part; LDS_WAIT(); __syncthreads();
        const float kS = eg * ((red[e] + red[128 + e]) + (red[256 + e] + red[384 + e])); const float vn = beta * (vs[t * 128 + e] - kS); float p2 = 0.f;
#pragma unroll
        for (int i = 0; i < 32; ++i) { S[i] = eg * S[i] + ks[t * 128 + 32 * dg + i] * vn; p2 += qs[t * 128 + 32 * dg + i] * S[i]; }
        red[512 + dg * 128 + e] = p2; LDS_WAIT(); __syncthreads();
        if (dg == 0) os[t * 128 + e] = (red[512 + e] + red[640 + e]) + (red[768 + e] + red[896 + e]);
    }
    float* dp = a.out + O_DS + ((size_t)unit * BHD + 32 * dg) * BHD + e;
#pragma unroll
    for (int i = 0; i < 32; ++i) dp[(size_t)i * BHD] = S[i];
    LDS_WAIT(); __syncthreads();
    if (wave < 4) { const int t = wave; const int row = MP + b * ST + t; const float o0 = os[t * 128 + lane], o1 = os[t * 128 + 64 + lane]; const float rstd = 1.0f / sqrtf(wave_sum(o0 * o0 + o1 * o1) * (1.0f / 128.0f) + EPS);
        const bf16* zp = Z + (size_t)row * ZLD + ZC_ZB + h * BHD; const float z0 = bf2f(zp[lane]), z1 = bf2f(zp[64 + lane]);
        bf16* op = OB + (size_t)row * QB + h * BHD; op[lane] = (bf16)f2bf(o0 * rstd * a.in[I_DNORM][lane] * siluf(z0)); op[64 + lane] = (bf16)f2bf(o1 * rstd * a.in[I_DNORM][64 + lane] * siluf(z1)); }
    LDS_WAIT(); __syncthreads();
}

constexpr int E1_Q = 0, E1_K = 17408, E1_V = 34816, E1_M = 52224, E1_AQ = 68608, E1_KDT = 77824, E1_UW = 96256, E1_G = 133120, E1_B = 133376, E1_SS = 133632;
constexpr int E1_P = 136, E1_P2 = 72;
DI void dn_e1_unit(const Args& a, LAS unsigned char* lds, int unit, int tid, int wave, int lane) {
    const bf16* Z = (const bf16*)(a.ws + WS_Z); const float* AB = (const float*)(a.ws + WS_AB);
    const int c = unit % NCH, bh = unit / NCH, h = bh & 15, b = bh >> 4;
    LAS bf16* Qs = (LAS bf16*)(lds + E1_Q); LAS bf16* Ks = (LAS bf16*)(lds + E1_K); LAS bf16* Vs = (LAS bf16*)(lds + E1_V); LAS float* Ms = (LAS float*)(lds + E1_M);
    LAS bf16* Aq = (LAS bf16*)(lds + E1_AQ); LAS bf16* KdT = (LAS bf16*)(lds + E1_KDT); LAS bf16* UWt = (LAS bf16*)(lds + E1_UW);
    LAS float* Gs = (LAS float*)(lds + E1_G); LAS float* Bs = (LAS float*)(lds + E1_B); LAS float* SS = (LAS float*)(lds + E1_SS);
    const int r = lane & 15, q = lane >> 4;
    float y[8][8]; int which = 0, cc = 0, tb = 0;
    LAS float* PS = (LAS float*)(lds + E1_UW);
    if (tid < 384) { const int ch = tid >> 3; tb = tid & 7; which = ch >> 4; cc = (ch & 15) * 8; const int col = which * QB + h * BHD + cc;
        float w[4][8];
#pragma unroll
        for (int j = 0; j < 4; ++j) { const f32x4 w0 = *(const GAS f32x4*)(a.in[I_CONVW] + (size_t)j * CONVD + col), w1 = *(const GAS f32x4*)(a.in[I_CONVW] + (size_t)j * CONVD + col + 4);
            w[j][0] = w0.x; w[j][1] = w0.y; w[j][2] = w0.z; w[j][3] = w0.w; w[j][4] = w1.x; w[j][5] = w1.y; w[j][6] = w1.z; w[j][7] = w1.w; }
        float xr[11][8];
#pragma unroll
        for (int k = 0; k < 11; ++k) { const int p = 64 * c + 8 * tb + k - 3 - 48; v4u v = {0u, 0u, 0u, 0u};
            if (p >= 0) { const int row = p < NMETA ? META0 + p : b * PSEQ + p - NMETA; v = *(const GAS v4u*)(Z + (size_t)row * ZLD + ZC_QKVB + col); }
            xr[k][0] = bflo(v.x); xr[k][1] = bfhi(v.x); xr[k][2] = bflo(v.y); xr[k][3] = bfhi(v.y); xr[k][4] = bflo(v.z); xr[k][5] = bfhi(v.z); xr[k][6] = bflo(v.w); xr[k][7] = bfhi(v.w); }
#pragma unroll
        for (int t = 0; t < 8; ++t) { float ss = 0.f;
#pragma unroll
            for (int e = 0; e < 8; ++e) { const float v = xr[t][e] * w[0][e] + xr[t + 1][e] * w[1][e] + xr[t + 2][e] * w[2][e] + xr[t + 3][e] * w[3][e]; const float sv = siluf(v); y[t][e] = sv; ss += sv * sv; }
            if (which < 2) PS[(which * 64 + 8 * tb + t) * 16 + (ch & 15)] = ss; }
    } else if (wave == 7) { const int i = lane; const int p = 64 * c + i - 48; float g = 0.f, be = 0.f;
        if (p >= 0) { const int row = p < NMETA ? META0 + p : b * PSEQ + p - NMETA; const float braw = AB[(size_t)row * 32 + h], araw = AB[(size_t)row * 32 + 16 + h];
            g = -__expf(a.in[I_ALOG][h]) * softplusf_(araw + a.in[I_DTB][h]); be = sigm(braw); }
#pragma unroll
        for (int o = 1; o < 64; o <<= 1) { const float t = __shfl_up(g, o); if (lane >= o) g += t; }
        Gs[i] = g; Bs[i] = be; }
    LDS_WAIT(); __syncthreads();
    if (tid < 128) { float t = 0.f;
#pragma unroll
        for (int k = 0; k < 16; ++k) t += PS[tid * 16 + k];
        SS[tid] = t; }
    LDS_WAIT(); __syncthreads();
    if (tid < 384) { LAS bf16* dst = which == 0 ? Qs : (which == 1 ? Ks : Vs);
#pragma unroll
        for (int t = 0; t < 8; ++t) { const int i = 8 * tb + t; float sc = 1.0f; if (which < 2) sc = (1.0f / sqrtf(SS[which * 64 + i] + EPS)) * (which == 0 ? 0.08838834764831845f : 1.0f);
            v4u o; o.x = pk2(y[t][0] * sc, y[t][1] * sc); o.y = pk2(y[t][2] * sc, y[t][3] * sc); o.z = pk2(y[t][4] * sc, y[t][5] * sc); o.w = pk2(y[t][6] * sc, y[t][7] * sc);
            *(LAS v4u*)(dst + i * E1_P + cc) = o; } }
    LDS_WAIT(); __syncthreads();
    { const int mb = wave >> 1;
#pragma unroll
      for (int nn = 0; nn < 2; ++nn) { const int nb = 2 * (wave & 1) + nn;
        const f32x4 kk = mm_lds<4>(Ks, E1_P, 16 * mb, Ks, E1_P, 16 * nb, r, q);
#pragma unroll
        for (int e = 0; e < 4; ++e) { const int i = 16 * mb + 4 * q + e, j = 16 * nb + r; Ms[i * 64 + j] = j < i ? Bs[i] * kk[e] * __expf(Gs[i] - Gs[j]) : 0.f; }
        const f32x4 qk = mm_lds<4>(Ks, E1_P, 16 * nb, Qs, E1_P, 16 * mb, r, q);
        const int i = 16 * mb + r; float v[4];
#pragma unroll
        for (int e = 0; e < 4; ++e) { const int j = 16 * nb + 4 * q + e; v[e] = j <= i ? qk[e] * __expf(Gs[i] - Gs[j]) : 0.f; }
        v2u w; w.x = pk2(v[0], v[1]); w.y = pk2(v[2], v[3]); *(LAS v2u*)(Aq + i * E1_P2 + 16 * nb + 4 * q) = w; } }
    LDS_WAIT(); __syncthreads();
    if (tid < 256) { const int col = tid; LAS bf16* xrow = UWt + col * E1_P2;
        for (int Ib = 0; Ib < 8; ++Ib) { float acc[8];
#pragma unroll
            for (int aa = 0; aa < 8; ++aa) { const int i = 8 * Ib + aa; const float bi = Bs[i]; acc[aa] = col < 128 ? bi * bf2f(Vs[i * E1_P + col]) : bi * __expf(Gs[i]) * bf2f(Ks[i * E1_P + col - 128]); }
            for (int Jb = 0; Jb < Ib; ++Jb) { const v4u xv = *(const LAS v4u*)(xrow + 8 * Jb);
                const float x0 = bflo(xv.x), x1 = bfhi(xv.x), x2 = bflo(xv.y), x3 = bfhi(xv.y), x4 = bflo(xv.z), x5 = bfhi(xv.z), x6 = bflo(xv.w), x7 = bfhi(xv.w);
#pragma unroll
                for (int aa = 0; aa < 8; ++aa) { const LAS float* mr = Ms + (8 * Ib + aa) * 64 + 8 * Jb; const f32x4 m0 = *(const LAS f32x4*)mr, m1 = *(const LAS f32x4*)(mr + 4);
                    acc[aa] -= ((m0.x * x0 + m0.y * x1) + (m0.z * x2 + m0.w * x3)) + ((m1.x * x4 + m1.y * x5) + (m1.z * x6 + m1.w * x7)); } }
#pragma unroll
            for (int aa = 1; aa < 8; ++aa) { const LAS float* mr = Ms + (8 * Ib + aa) * 64 + 8 * Ib; const f32x4 m0 = *(const LAS f32x4*)mr, m1 = *(const LAS f32x4*)(mr + 4);
                const float mm[8] = {m0.x, m0.y, m0.z, m0.w, m1.x, m1.y, m1.z, m1.w};
#pragma unroll
                for (int bb = 0; bb < 8; ++bb) if (bb < aa) acc[aa] -= mm[bb] * acc[bb]; }
            v4u o; o.x = pk2(acc[0], acc[1]); o.y = pk2(acc[2], acc[3]); o.z = pk2(acc[4], acc[5]); o.w = pk2(acc[6], acc[7]);
            *(LAS v4u*)(xrow + 8 * Ib) = o; }
    } else { const int t = tid - 256; const int dk = t & 127, half = t >> 7; const float gl = Gs[63];
#pragma unroll
        for (int i8 = 0; i8 < 4; ++i8) { float v[8];
#pragma unroll
            for (int e = 0; e < 8; ++e) { const int i = 32 * half + 8 * i8 + e; v[e] = bf2f(Ks[i * E1_P + dk]) * __expf(gl - Gs[i]); }
            v4u o; o.x = pk2(v[0], v[1]); o.y = pk2(v[2], v[3]); o.z = pk2(v[4], v[5]); o.w = pk2(v[6], v[7]); *(LAS v4u*)(KdT + dk * E1_P2 + 32 * half + 8 * i8) = o; } }
    LDS_WAIT(); __syncthreads();
#ifndef DBG_NOSTEP3
    unsigned char* ws = a.ws;
    {
        const int mb = wave >> 1, i = 16 * mb + r; const float eg = __expf(Gs[i]);
#pragma unroll
        for (int n8 = 0; n8 < 8; ++n8) { const int nb = 8 * (wave & 1) + n8;
            const f32x4 p = mm_lds<2>(UWt, E1_P2, 16 * nb, Aq, E1_P2, 16 * mb, r, q);
            if (nb < 8) { v2u w; w.x = pk2(p[0], p[1]); w.y = pk2(p[2], p[3]); *(GAS v2u*)((bf16*)(ws + DN_OL) + (size_t)unit * 8192 + i * 128 + 16 * nb + 4 * q) = w; }
            else { const int dk0 = 16 * (nb - 8) + 4 * q; const v2u qv = *(const LAS v2u*)(Qs + i * E1_P + dk0);
                v2u w; w.x = pk2(bflo(qv.x) * eg - p[0], bfhi(qv.x) * eg - p[1]); w.y = pk2(bflo(qv.y) * eg - p[2], bfhi(qv.y) * eg - p[3]);
                *(GAS v2u*)((bf16*)(ws + DN_QE) + (size_t)unit * 8192 + i * 128 + dk0) = w; } }
    }
    {
        const int mb = wave; const float gl = __expf(Gs[63]);
#pragma unroll
        for (int nb = 0; nb < 8; ++nb) {
            const f32x4 p = mm_lds<2>(KdT, E1_P2, 16 * mb, UWt, E1_P2, 16 * nb, r, q);
            v2u w; w.x = pk2(p[0], p[1]); w.y = pk2(p[2], p[3]);
            *(GAS v2u*)(ws + DN_BC + (size_t)unit * 32768 + ((size_t)((nb * 4 + (mb >> 1)) * 64 + lane) * 2 + (mb & 1)) * 8) = w; }
#pragma unroll
        for (int nb = 0; nb < 8; ++nb) {
            const f32x4 p = mm_lds<2>(UWt, E1_P2, 128 + 16 * nb, KdT, E1_P2, 16 * mb, r, q);
            float v[4];
#pragma unroll
            for (int e = 0; e < 4; ++e) v[e] = ((16 * mb + r) == (16 * nb + 4 * q + e) ? gl : 0.f) - p[e];
            v2u w; w.x = pk2(v[0], v[1]); w.y = pk2(v[2], v[3]);
            *(GAS v2u*)(ws + DN_AC + (size_t)unit * 32768 + ((size_t)((mb * 4 + (nb >> 1)) * 64 + lane) * 2 + (nb & 1)) * 8) = w; }
    }
#endif
    LDS_WAIT(); __syncthreads();
}

DI void dn_scan(const Args& a, LAS unsigned char* lds, int bh, int tid, int wave, int lane) {
    unsigned char* ws = a.ws; const int r = lane & 15, q = lane >> 4, s = wave;
    f32x4 S[8];
#pragma unroll
    for (int rb = 0; rb < 8; ++rb) S[rb] = (f32x4){0.f, 0.f, 0.f, 0.f};
    const unsigned char* ac = ws + DN_AC + (size_t)(bh * NCH) * 32768;
#pragma unroll
    for (int p = 0; p < 4; ++p) __builtin_amdgcn_global_load_lds((const unsigned*)(ac + (wave * 4 + p) * 1024 + lane * 16), (LAS unsigned*)(lds + (wave * 4 + p) * 1024), 16, 0, 0);
    for (int c = 0; c < NCH; ++c) {
        const int unit = bh * NCH + c;
        asm volatile("s_waitcnt vmcnt(0)" ::: "memory"); __syncthreads();
        if (c + 1 < NCH) { const unsigned char* an = ac + (size_t)(c + 1) * 32768; const int so = ((c + 1) & 1) * 32768;
#pragma unroll
            for (int p = 0; p < 4; ++p) __builtin_amdgcn_global_load_lds((const unsigned*)(an + (wave * 4 + p) * 1024 + lane * 16), (LAS unsigned*)(lds + so + (wave * 4 + p) * 1024), 16, 0, 0); }
        v4u Bv[4];
#pragma unroll
        for (int p = 0; p < 4; ++p) Bv[p] = *(const GAS v4u*)(ws + DN_BC + (size_t)unit * 32768 + (size_t)((s * 4 + p) * 64 + lane) * 16);
        bf16* st = (bf16*)(ws + DN_ST) + (size_t)unit * 16384 + (16 * s + r) * 128 + 4 * q;
#pragma unroll
        for (int rb = 0; rb < 8; ++rb) { v2u w; w.x = pk2(S[rb][0], S[rb][1]); w.y = pk2(S[rb][2], S[rb][3]); *(GAS v2u*)(st + 16 * rb) = w; }
        bf16x8 Sf[4];
#pragma unroll
        for (int j = 0; j < 4; ++j) Sf[j] = pack8(S[2 * j][0], S[2 * j][1], S[2 * j][2], S[2 * j][3], S[2 * j + 1][0], S[2 * j + 1][1], S[2 * j + 1][2], S[2 * j + 1][3]);
        const LAS unsigned char* slot = lds + (c & 1) * 32768 + lane * 16;
#pragma unroll
        for (int rb = 0; rb < 8; ++rb) { f32x4 acc = {0.f, 0.f, 0.f, 0.f};
#pragma unroll
            for (int j = 0; j < 4; ++j) { const bf16x8 af = *(const LAS bf16x8*)(slot + (rb * 4 + j) * 1024); acc = MFMA16(af, Sf[j], acc); }
            S[rb] = acc; }
#pragma unroll
        for (int p = 0; p < 4; ++p) {
            S[2 * p][0] += bflo(Bv[p].x); S[2 * p][1] += bfhi(Bv[p].x); S[2 * p][2] += bflo(Bv[p].y); S[2 * p][3] += bfhi(Bv[p].y);
            S[2 * p + 1][0] += bflo(Bv[p].z); S[2 * p + 1][1] += bfhi(Bv[p].z); S[2 * p + 1][2] += bflo(Bv[p].w); S[2 * p + 1][3] += bfhi(Bv[p].w); }
    }
    float* dp = a.out + O_DP + (size_t)bh * BHD * BHD + 16 * s + r;
#pragma unroll
    for (int rb = 0; rb < 8; ++rb)
#pragma unroll
        for (int e = 0; e < 4; ++e) { float v_ = S[rb][e];
#ifdef DBG_SANITIZE
            if (!(fabsf(v_) < 1e30f)) v_ = 12345.0f;
#endif
            dp[(size_t)(16 * rb + 4 * q + e) * BHD] = v_; }
    asm volatile("s_waitcnt vmcnt(0)" ::: "memory"); __syncthreads();
}

constexpr int N_E2_ITEMS = PB * BH * 64 * 4;
DI void dn_e2_item(const Args& a, int item, int lane) {
    unsigned char* ws = a.ws; const bf16* Z = (const bf16*)(ws + WS_Z); bf16* OB = (bf16*)(ws + WS_OB);
    const int r = lane & 15, q = lane >> 4; const int mb = item & 3, cu = item >> 2; const int c = (cu & 63) + 1, bh = cu >> 6, h = bh & 15, b = bh >> 4; const int unit = bh * NCH + c;
    const bf16* qe = (const bf16*)(ws + DN_QE) + (size_t)unit * 8192 + (16 * mb + r) * 128 + 8 * q;
    bf16x8 qf[4];
#pragma unroll
    for (int ks = 0; ks < 4; ++ks) qf[ks] = __builtin_bit_cast(bf16x8, *(const GAS v4u*)(qe + 32 * ks));
    const bf16* stp = (const bf16*)(ws + DN_ST) + (size_t)unit * 16384 + r * 128 + 8 * q;
    const bf16* olp = (const bf16*)(ws + DN_OL) + (size_t)unit * 8192 + (16 * mb + r) * 128 + 4 * q;
    f32x4 o[8]; float ss = 0.f;
#pragma unroll
    for (int nb = 0; nb < 8; ++nb) { f32x4 acc = {0.f, 0.f, 0.f, 0.f};
#pragma unroll
        for (int ks = 0; ks < 4; ++ks) { const bf16x8 sf = __builtin_bit_cast(bf16x8, *(const GAS v4u*)(stp + (size_t)nb * 16 * 128 + 32 * ks)); acc = MFMA16(sf, qf[ks], acc); }
        const v2u ol = *(const GAS v2u*)(olp + 16 * nb); acc[0] += bflo(ol.x); acc[1] += bfhi(ol.x); acc[2] += bflo(ol.y); acc[3] += bfhi(ol.y);
        o[nb] = acc; ss += (acc[0] * acc[0] + acc[1] * acc[1]) + (acc[2] * acc[2] + acc[3] * acc[3]); }
    ss += __shfl_xor(ss, 16); ss += __shfl_xor(ss, 32);
    const float rstd = 1.0f / sqrtf(ss * (1.0f / 128.0f) + EPS);
    const int row = b * PSEQ + 64 * (c - 1) + 16 * mb + r;
    const bf16* zp = Z + (size_t)row * ZLD + ZC_ZB + h * BHD + 4 * q; bf16* op = OB + (size_t)row * QB + h * BHD + 4 * q; const float* dn = a.in[I_DNORM] + 4 * q;
#pragma unroll
    for (int nb = 0; nb < 8; ++nb) { const v2u zv = *(const GAS v2u*)(zp + 16 * nb); const f32x4 g = *(const GAS f32x4*)(dn + 16 * nb);
        v2u w; w.x = pk2(o[nb][0] * rstd * g.x * siluf(bflo(zv.x)), o[nb][1] * rstd * g.y * siluf(bfhi(zv.x))); w.y = pk2(o[nb][2] * rstd * g.z * siluf(bflo(zv.y)), o[nb][3] * rstd * g.w * siluf(bfhi(zv.y)));
        *(GAS v2u*)(op + 16 * nb) = w; }
}

DI float* out_row(const Args& a, int m) { return a.out + (m < MP ? O_YP + (size_t)m * DM : O_YS + (size_t)(m - MP) * DM); }
DI void norm1_row(const Args& a, int m, int lane) {
    const float* SQ = (const float*)(a.ws + WS_SQ1) + (size_t)m * 64; const float rstd1 = 1.0f / sqrtf(wave_sum(SQ[lane]) * (1.0f / DM) + EPS);
    const GAS f32x4* hr = (const GAS f32x4*)h_row(a, m) + lane; const GAS f32x4* rr = (const GAS f32x4*)((const float*)(a.ws + WS_RAW) + (size_t)m * DM) + lane;
    const GAS f32x4* wp = (const GAS f32x4*)a.in[I_NMIXPOST] + lane; const GAS f32x4* wm = (const GAS f32x4*)a.in[I_NMLPPRE] + lane;
    GAS f32x4* orow = (GAS f32x4*)out_row(a, m) + lane; GAS v2u* xn = (GAS v2u*)((bf16*)(a.ws + WS_XN) + (size_t)m * DM) + lane;
    f32x4 v[16]; float s = 0.f;
#pragma unroll
    for (int j = 0; j < 16; ++j) { const f32x4 hh = hr[64 * j], rw = rr[64 * j], g = wp[64 * j]; f32x4 t; t.x = hh.x + rw.x * rstd1 * g.x; t.y = hh.y + rw.y * rstd1 * g.y; t.z = hh.z + rw.z * rstd1 * g.z; t.w = hh.w + rw.w * rstd1 * g.w;
        v[j] = t; orow[64 * j] = t; s += (t.x * t.x + t.y * t.y) + (t.z * t.z + t.w * t.w); }
    const float rstd2 = 1.0f / sqrtf(wave_sum(s) * (1.0f / DM) + EPS);
#pragma unroll
    for (int j = 0; j < 16; ++j) { const f32x4 g = wm[64 * j]; v2u o; o.x = pk2(v[j].x * rstd2 * g.x, v[j].y * rstd2 * g.y); o.y = pk2(v[j].z * rstd2 * g.z, v[j].w * rstd2 * g.w); xn[64 * j] = o; }
}
DI void norm2_row(const Args& a, int m, int lane) {
    const float* SQ = (const float*)(a.ws + WS_SQ2) + (size_t)m * 64; const float rstd = 1.0f / sqrtf(wave_sum(SQ[lane]) * (1.0f / DM) + EPS);
    const GAS f32x4* rr = (const GAS f32x4*)((const float*)(a.ws + WS_RAW) + (size_t)m * DM) + lane; const GAS f32x4* wp = (const GAS f32x4*)a.in[I_NMLPPOST] + lane; GAS f32x4* orow = (GAS f32x4*)out_row(a, m) + lane;
#pragma unroll
    for (int j = 0; j < 16; ++j) { const f32x4 hh = orow[64 * j], rw = rr[64 * j], g = wp[64 * j]; f32x4 t; t.x = hh.x + rw.x * rstd * g.x; t.y = hh.y + rw.y * rstd * g.y; t.z = hh.z + rw.z * rstd * g.z; t.w = hh.w + rw.w * rstd * g.w; orow[64 * j] = t; }
}

#ifndef MK_ONE_LAUNCH
#define MK_ONE_LAUNCH 1
#endif
constexpr int NPHASE = 11;
constexpr int NSCAN = PB * BH;
constexpr int N_MIX_ITEMS = 4096;
__global__ void __launch_bounds__(NTHR, 2) fwd(Args args) {
    extern __shared__ __attribute__((aligned(16))) unsigned char lds_raw[];
    LAS unsigned char* lds = (LAS unsigned char*)lds_raw;
    const int tid = threadIdx.x, lane = tid & 63, wave = __builtin_amdgcn_readfirstlane(tid >> 6);
    const int lo = args.ph_lo, hi = args.ph_hi; const int G = gridDim.x, bid = blockIdx.x;
    volatile LAS unsigned* MISC = (volatile LAS unsigned*)(lds + MISC_OFF);
    for (int u = tid; u < (LDS_BYTES - LDSCTL_OFF) / 4; u += NTHR) ((LAS unsigned*)(lds + LDSCTL_OFF))[u] = 0u;
    __syncthreads();
#if MK_ONE_LAUNCH
    XcdBarrier bar = xcd_barrier_post((unsigned*)(args.ws + WS_CTL) + CW_BAR, MISC + 8);
#define GRID_BAR() xcd_barrier(bar)
#else
    (void)MISC;
#define GRID_BAR() do {} while (0)
#endif
#ifndef PHASE_MASK
#define PHASE_MASK 0x7ff
#endif
#define IN(k) ((((PHASE_MASK) >> (k)) & 1) && lo <= (k) && (k) < hi)
#define BOTH(k) (IN(k) && IN((k) + 1))
    if (IN(0)) { p0_prologue(args, lds, wave, lane); if (BOTH(0)) GRID_BAR(); }
    if (IN(1)) {
        pg8::Gemm g{(const bf16*)(args.ws + WS_XN), (const bf16*)(args.ws + WS_WIN), MPAD, NINP, DM}; pg8::StaticOrder S; S.init(MPAD, NINP, G, bid);
        pg8::EpiZ E{(bf16*)(args.ws + WS_Z), ZLD, MVALID, ZLD, (float*)(args.ws + WS_AB)};
        pg8::gemm_phase<pg8::EpiZ, pg8::StaticOrder, true, true>(lds + RING_OFF, g, S, E);
        if (BOTH(1)) GRID_BAR();
    }
    if (IN(2)) {
        p2_state_outputs(args);
        for (int u = bid; u < NUNIT_DN; u += G) dn_e1_unit(args, lds, u, tid, wave, lane);
        if (BOTH(2)) GRID_BAR();
    }
    if (IN(3)) {
        const bool has_workers = G > NSCAN;
        if (bid < NSCAN || !has_workers) { for (int bh = bid; bh < NSCAN; bh += G) dn_scan(args, lds, bh, tid, wave, lane); }
        if (bid >= NSCAN || !has_workers) { const int W = has_workers ? G - NSCAN : G, w = has_workers ? bid - NSCAN : bid;
            for (int i = w; i < N_MIX_ITEMS; i += W) { const int type = (i + (i >> 5)) & 3, idx = i >> 2;
                if (type == 0) attn_prompt_unit(args, lds, idx, tid, wave, lane);
                else if (type == 1) attn_sample_unit(args, lds, idx, tid, wave, lane);
                else dn_sample_unit(args, lds, 2 * idx + (type - 2), tid, wave, lane); } }
        if (BOTH(3)) GRID_BAR();
    }
    if (IN(4)) {
        for (int it = bid * NWAVES + wave; it < N_E2_ITEMS; it += G * NWAVES) dn_e2_item(args, it, lane);
        if (BOTH(4)) GRID_BAR();
    }
    if (IN(5)) {
        { pg8::Gemm g{(const bf16*)(args.ws + WS_OA), (const bf16*)(args.ws + WS_WA), MM, DM, QB}; pg8::StaticOrder S; S.init(MM, DM, G, bid);
          pg8::EpiGateF32 E{(float*)(args.ws + WS_RAW), DM, (const bf16*)(args.ws + WS_Z) + ZC_GA, ZLD};
          pg8::gemm_phase<pg8::EpiGateF32, pg8::StaticOrder, true, true>(lds + RING_OFF, g, S, E); }
        __builtin_amdgcn_fence(__ATOMIC_ACQUIRE, "agent"); asm volatile("s_waitcnt vmcnt(0)" ::: "memory"); __syncthreads();
        { pg8::Gemm g{(const bf16*)(args.ws + WS_OB), (const bf16*)(args.ws + WS_WB), MM, DM, QB}; pg8::StaticOrder S; S.init(MM, DM, G, bid);
          pg8::EpiGateAddBf16 E{(bf16*)(args.ws + WS_MERGED), (const float*)(args.ws + WS_RAW), DM, (const bf16*)(args.ws + WS_Z) + ZC_GB, ZLD};
          pg8::gemm_phase<pg8::EpiGateAddBf16, pg8::StaticOrder, true, true>(lds + RING_OFF, g, S, E); }
        if (BOTH(5)) GRID_BAR();
    }
    if (IN(6)) {
        pg8::Gemm g{(const bf16*)(args.ws + WS_MERGED), (const bf16*)(args.ws + WS_WOUT), MM, DM, DM}; pg8::StaticOrder S; S.init(MM, DM, G, bid);
        pg8::EpiRawSq E{(float*)(args.ws + WS_RAW), DM, (float*)(args.ws + WS_SQ1), 64};
        pg8::gemm_phase<pg8::EpiRawSq, pg8::StaticOrder, true, true>(lds + RING_OFF, g, S, E);
        if (BOTH(6)) GRID_BAR();
    }
    if (IN(7)) {
        for (int m = bid * NWAVES + wave; m < MM; m += G * NWAVES) norm1_row(args, m, lane);
        if (BOTH(7)) GRID_BAR();
    }
    if (IN(8)) {
        pg8::Gemm g{(const bf16*)(args.ws + WS_XN), (const bf16*)(args.ws + WS_WUP), MM, DFF, DM}; pg8::StaticOrder S; S.init(MM, DFF, G, bid);
        pg8::EpiRelu2 E{(bf16*)(args.ws + WS_UACT), DFF};
        pg8::gemm_phase<pg8::EpiRelu2, pg8::StaticOrder, true, true>(lds + RING_OFF, g, S, E);
        if (BOTH(8)) GRID_BAR();
    }
    if (IN(9)) {
        pg8::Gemm g{(const bf16*)(args.ws + WS_UACT), (const bf16*)(args.ws + WS_WDN), MM, DM, DFF}; pg8::StaticOrder S; S.init(MM, DM, G, bid);
        pg8::EpiRawSq E{(float*)(args.ws + WS_RAW), DM, (float*)(args.ws + WS_SQ2), 64};
        pg8::gemm_phase<pg8::EpiRawSq, pg8::StaticOrder, true, true>(lds + RING_OFF, g, S, E);
        if (BOTH(9)) GRID_BAR();
    }
    if (IN(10)) {
        for (int m = bid * NWAVES + wave; m < MM; m += G * NWAVES) norm2_row(args, m, lane);
    }
#undef IN
#undef BOTH
}

extern "C" void kernel_launch(void* const* d_in, const int* in_sizes, int n_in, void* d_out, int out_size, void* d_ws, size_t ws_size, hipStream_t stream) {
    static int grid = 0;
    if (grid == 0) {
        if (n_in != 22 || out_size != (int)O_END || ws_size < WS_END) { fprintf(stderr, "kernel_launch: unexpected shapes n_in %d out %d ws %zu\n", n_in, out_size, ws_size); grid = -1; return; }
        int dev = 0, cus = 0, per_cu = 0;
        if (hipGetDevice(&dev) != hipSuccess || hipDeviceGetAttribute(&cus, hipDeviceAttributeMultiprocessorCount, dev) != hipSuccess) { grid = -1; return; }
        if (hipFuncSetAttribute((const void*)fwd, hipFuncAttributeMaxDynamicSharedMemorySize, LDS_BYTES) != hipSuccess) { fprintf(stderr, "kernel_launch: hipFuncSetAttribute failed\n"); grid = -1; return; }
        if (hipOccupancyMaxActiveBlocksPerMultiprocessor(&per_cu, (const void*)fwd, NTHR, LDS_BYTES) != hipSuccess || per_cu < 1) { fprintf(stderr, "kernel_launch: occupancy query reports %d\n", per_cu); }
        (void)hipGetLastError();
        grid = cus;
    }
    if (grid < 0) return;
    (void)hipMemsetAsync((char*)d_ws + WS_CTL, 0, CTL_ZERO_BYTES, stream);
    Args a{};
    for (int i = 0; i < 22; ++i) a.in[i] = (const float*)d_in[i];
    a.out = (float*)d_out; a.ws = (unsigned char*)d_ws;
#if MK_ONE_LAUNCH
    a.ph_lo = 0; a.ph_hi = NPHASE; hipLaunchKernelGGL(fwd, dim3(grid), dim3(NTHR), LDS_BYTES, stream, a);
#else
    for (int p = 0; p < NPHASE; ++p) { a.ph_lo = p; a.ph_hi = p + 1; hipLaunchKernelGGL(fwd, dim3(grid), dim3(NTHR), LDS_BYTES, stream, a); }
#endif
}
```

```cpp
#include <hip/hip_runtime.h>
#include <cstdio>
#include <cstdint>
namespace pg8 {
#define PG8_LAS __attribute__((address_space(3)))
typedef unsigned short bf16_t;
typedef short bf16x8 __attribute__((ext_vector_type(8)));
typedef float f32x4 __attribute__((ext_vector_type(4)));
typedef unsigned u32x4 __attribute__((ext_vector_type(4)));
constexpr int BM = 256, BK = 64, HALF = 128, HTB = HALF * BK * 2  , STAGE_BYTES = 8 * HTB, NXCD = 8, WGM = 8;

__host__ __device__ __forceinline__ int lds_byte(int r, int c) { const int st = (r >> 4) * 2 + (c >> 5), rr = r & 15, cc = c & 31, ob = rr * 64 + cc * 2; return st * 1024 + (ob ^ (((ob >> 9) & 1) << 5)); }
__host__ __device__ __forceinline__ void stage_rc(int b, int& R, int& C) { const int st = b / 1024, sb = b % 1024, swz = sb ^ (((sb >> 9) & 1) << 5); R = (st >> 1) * 16 + swz / 64; C = (st & 1) * 32 + (swz % 64) / 2; }
__host__ __device__ __forceinline__ int perm32(int rho) { const int n = rho >> 4, i = rho & 15; return 8 * (i >> 2) + 4 * n + (i & 3); }

struct Unit { int pm, pn, pk; };
struct Gemm { const bf16_t* A; const bf16_t* Bt; int M, N, K; int lda, ldb; };

struct StaticOrder {
    int nM, nN, nwg, G, c;
    __host__ __device__ void init(int M, int N, int G_, int c_) { nM = M / BM; nN = N / BM; nwg = nM * nN; G = G_; c = c_; }
    __host__ __device__ bool next(int i, Unit& u) const {
        const long L = (long)i * G + c; if (L >= nwg) return false;
        int wgid = (int)L; { const int q = nwg / NXCD, r = nwg % NXCD, xcd = wgid % NXCD, off = wgid / NXCD; wgid = (xcd < r ? xcd * (q + 1) : r * (q + 1) + (xcd - r) * q) + off; }
        const int nig = WGM * nN, gid = wgid / nig, fm = gid * WGM, gsz = (nM - fm) < WGM ? (nM - fm) : WGM;
        u.pm = fm + ((wgid % nig) % gsz); u.pn = (wgid % nig) / gsz; u.pk = 0; return true;
    }
    __device__ __forceinline__ void a_ready(const Unit&) const {}
    __device__ __forceinline__ void done(const Unit&) const {}
};

typedef float f32x2_t __attribute__((ext_vector_type(2))); typedef __bf16 bf16x2_t __attribute__((ext_vector_type(2)));
__device__ __forceinline__ unsigned cvt_pk_bf16(float lo, float hi) { f32x2_t v = {lo, hi}; bf16x2_t b = __builtin_convertvector(v, bf16x2_t); return __builtin_bit_cast(unsigned, b); }
__device__ __forceinline__ float bf_lo(unsigned w) { return __uint_as_float(w << 16); }
__device__ __forceinline__ float bf_hi(unsigned w) { return __uint_as_float(w & 0xffff0000u); }
__device__ __forceinline__ float sigmoidf_(float x) { return __builtin_amdgcn_rcpf(1.0f + __expf(-x)); }

struct EpiZ {
    static constexpr bool PERM = true, AFTER_DRAIN = false;
    bf16_t* Z; int ldz; int nrows; int zcols; float* AB;
    __device__ __forceinline__ void operator()(const f32x4 (&acc)[2][2][4][2], const Unit& u, int wr, int wc, int fr, int fq) const {
        const int row0 = u.pm * BM + wr * 64 + fr; const int colt = u.pn * BM;
        if (colt >= zcols) {
            if (wc == 0) {
#pragma unroll
                for (int ai = 0; ai < 2; ++ai)
#pragma unroll
                    for (int m = 0; m < 4; ++m) { const int row = row0 + ai * HALF + m * 16;
                        if (row < nrows) { float* p = AB + (size_t)row * 32 + 8 * fq; *(f32x4*)p = acc[ai][0][m][0]; *(f32x4*)(p + 4) = acc[ai][0][m][1]; } }
            }
            return;
        }
        const int col0 = colt + wc * 32 + 8 * fq;
#pragma unroll
        for (int ai = 0; ai < 2; ++ai)
#pragma unroll
            for (int m = 0; m < 4; ++m) { const int row = row0 + ai * HALF + m * 16;
                if (row < nrows) { bf16_t* rowp = Z + (size_t)row * ldz + col0;
#pragma unroll
                    for (int bj = 0; bj < 2; ++bj) { const f32x4 v0 = acc[ai][bj][m][0], v1 = acc[ai][bj][m][1];
                        u32x4 w; w.x = cvt_pk_bf16(v0[0], v0[1]); w.y = cvt_pk_bf16(v0[2], v0[3]); w.z = cvt_pk_bf16(v1[0], v1[1]); w.w = cvt_pk_bf16(v1[2], v1[3]);
                        *(u32x4*)(rowp + bj * HALF) = w; } } }
    }
};
struct EpiGateF32 {
    static constexpr bool PERM = true, AFTER_DRAIN = false;
    float* T1; int ldc; const bf16_t* G; int ldg;
    __device__ __forceinline__ void operator()(const f32x4 (&acc)[2][2][4][2], const Unit& u, int wr, int wc, int fr, int fq) const {
        const int row0 = u.pm * BM + wr * 64 + fr; const int col0 = u.pn * BM + wc * 32 + 8 * fq;
#pragma unroll
        for (int ai = 0; ai < 2; ++ai)
#pragma unroll
            for (int m = 0; m < 4; ++m) { const int row = row0 + ai * HALF + m * 16;
#pragma unroll
                for (int bj = 0; bj < 2; ++bj) { const u32x4 g = *(const u32x4*)(G + (size_t)row * ldg + col0 + bj * HALF);
                    const f32x4 v0 = acc[ai][bj][m][0], v1 = acc[ai][bj][m][1]; f32x4 o0, o1;
                    o0[0] = v0[0] * sigmoidf_(bf_lo(g.x)); o0[1] = v0[1] * sigmoidf_(bf_hi(g.x)); o0[2] = v0[2] * sigmoidf_(bf_lo(g.y)); o0[3] = v0[3] * sigmoidf_(bf_hi(g.y));
                    o1[0] = v1[0] * sigmoidf_(bf_lo(g.z)); o1[1] = v1[1] * sigmoidf_(bf_hi(g.z)); o1[2] = v1[2] * sigmoidf_(bf_lo(g.w)); o1[3] = v1[3] * sigmoidf_(bf_hi(g.w));
                    float* p = T1 + (size_t)row * ldc + col0 + bj * HALF; *(f32x4*)p = o0; *(f32x4*)(p + 4) = o1; } }
    }
};
struct EpiGateAddBf16 {
    static constexpr bool PERM = true, AFTER_DRAIN = false;
    bf16_t* O; const float* T1; int ldc; const bf16_t* G; int ldg;
    __device__ __forceinline__ void operator()(const f32x4 (&acc)[2][2][4][2], const Unit& u, int wr, int wc, int fr, int fq) const {
        const int row0 = u.pm * BM + wr * 64 + fr; const int col0 = u.pn * BM + wc * 32 + 8 * fq;
#pragma unroll
        for (int ai = 0; ai < 2; ++ai)
#pragma unroll
            for (int m = 0; m < 4; ++m) { const int row = row0 + ai * HALF + m * 16;
#pragma unroll
                for (int bj = 0; bj < 2; ++bj) { const u32x4 g = *(const u32x4*)(G + (size_t)row * ldg + col0 + bj * HALF);
                    const float* tp = T1 + (size_t)row * ldc + col0 + bj * HALF; const f32x4 t0 = *(const f32x4*)tp, t1 = *(const f32x4*)(tp + 4);
                    const f32x4 v0 = acc[ai][bj][m][0], v1 = acc[ai][bj][m][1]; f32x4 o0, o1;
                    o0[0] = t0[0] + v0[0] * sigmoidf_(bf_lo(g.x)); o0[1] = t0[1] + v0[1] * sigmoidf_(bf_hi(g.x)); o0[2] = t0[2] + v0[2] * sigmoidf_(bf_lo(g.y)); o0[3] = t0[3] + v0[3] * sigmoidf_(bf_hi(g.y));
                    o1[0] = t1[0] + v1[0] * sigmoidf_(bf_lo(g.z)); o1[1] = t1[1] + v1[1] * sigmoidf_(bf_hi(g.z)); o1[2] = t1[2] + v1[2] * sigmoidf_(bf_lo(g.w)); o1[3] = t1[3] + v1[3] * sigmoidf_(bf_hi(g.w));
                    u32x4 w; w.x = cvt_pk_bf16(o0[0], o0[1]); w.y = cvt_pk_bf16(o0[2], o0[3]); w.z = cvt_pk_bf16(o1[0], o1[1]); w.w = cvt_pk_bf16(o1[2], o1[3]);
                    *(u32x4*)(O + (size_t)row * ldc + col0 + bj * HALF) = w; } }
    }
};
struct EpiRawSq {
    static constexpr bool PERM = false, AFTER_DRAIN = false;
    float* C; int ldc; float* SQ; int ldsq;
    __device__ __forceinline__ void operator()(const f32x4 (&acc)[2][2][4][2], const Unit& u, int wr, int wc, int fr, int fq) const {
        const int row0 = u.pm * BM + wr * 64 + fr; const int col0 = u.pn * BM + wc * 32 + 4 * fq;
#pragma unroll
        for (int ai = 0; ai < 2; ++ai)
#pragma unroll
            for (int m = 0; m < 4; ++m) { const int row = row0 + ai * HALF + m * 16; float* p = C + (size_t)row * ldc + col0; float s = 0.f;
#pragma unroll
                for (int bj = 0; bj < 2; ++bj)
#pragma unroll
                    for (int n = 0; n < 2; ++n) { const f32x4 v = acc[ai][bj][m][n]; *(f32x4*)(p + bj * HALF + n * 16) = v; s += (v[0] * v[0] + v[1] * v[1]) + (v[2] * v[2] + v[3] * v[3]); }
                s += __shfl_xor(s, 16); s += __shfl_xor(s, 32);
                if (fq == 0) SQ[(size_t)row * ldsq + 4 * u.pn + wc] = s; }
    }
};
struct EpiRelu2 {
    static constexpr bool PERM = true, AFTER_DRAIN = false;
    bf16_t* O; int ldc;
    __device__ __forceinline__ void operator()(const f32x4 (&acc)[2][2][4][2], const Unit& u, int wr, int wc, int fr, int fq) const {
        const int row0 = u.pm * BM + wr * 64 + fr; const int col0 = u.pn * BM + wc * 32 + 8 * fq;
#pragma unroll
        for (int ai = 0; ai < 2; ++ai)
#pragma unroll
            for (int m = 0; m < 4; ++m) { bf16_t* rowp = O + (size_t)(row0 + ai * HALF + m * 16) * ldc + col0;
#pragma unroll
                for (int bj = 0; bj < 2; ++bj) { f32x4 v0 = acc[ai][bj][m][0], v1 = acc[ai][bj][m][1];
#pragma unroll
                    for (int e = 0; e < 4; ++e) { const float a = fmaxf(v0[e], 0.f), b = fmaxf(v1[e], 0.f); v0[e] = a * a; v1[e] = b * b; }
                    u32x4 w; w.x = cvt_pk_bf16(v0[0], v0[1]); w.y = cvt_pk_bf16(v0[2], v0[3]); w.z = cvt_pk_bf16(v1[0], v1[1]); w.w = cvt_pk_bf16(v1[2], v1[3]);
                    *(u32x4*)(rowp + bj * HALF) = w; } }
    }
};

struct EpiPart {
    static constexpr bool PERM = false, AFTER_DRAIN = false;
    float* P; int ldc; size_t pstride;
    __device__ __forceinline__ void operator()(const f32x4 (&acc)[2][2][4][2], const Unit& u, int wr, int wc, int fr, int fq) const {
        const int row0 = u.pm * BM + wr * 64 + fr; const int col0 = u.pn * BM + wc * 32 + 4 * fq; float* base = P + (size_t)u.pk * pstride;
#pragma unroll
        for (int ai = 0; ai < 2; ++ai)
#pragma unroll
            for (int m = 0; m < 4; ++m) { float* p = base + (size_t)(row0 + ai * HALF + m * 16) * ldc + col0;
#pragma unroll
                for (int bj = 0; bj < 2; ++bj)
#pragma unroll
                    for (int n = 0; n < 2; ++n) *(f32x4*)(p + bj * HALF + n * 16) = acc[ai][bj][m][n]; }
    }
};
struct PieceOrder {
    int npieces, nN, nsplit, c;
    __host__ __device__ void init(int M, int N, int nsplit_, int c_) { nN = N / BM; nsplit = nsplit_; npieces = (M / BM) * nN * nsplit_; c = c_; }
    __host__ __device__ bool next(int i, Unit& u) const { if (i > 0 || c >= npieces) return false; u.pk = c % nsplit; const int t = c / nsplit; u.pn = t % nN; u.pm = t / nN; return true; }
    __device__ __forceinline__ void a_ready(const Unit&) const {}
    __device__ __forceinline__ void done(const Unit&) const {}
};

template <class Epi, class Sched, bool ALIGN_EPI = false, bool SP2 = false>
__device__ __forceinline__ void gemm_phase(PG8_LAS unsigned char* lds, const Gemm g, const Sched& S, const Epi& E) {
    const int tid = threadIdx.x, wid = __builtin_amdgcn_readfirstlane(tid >> 6), lane = tid & 63, wr = wid >> 2, wc = wid & 3, fr = lane & 15, fq = lane >> 4;
    const int K = g.K, nt = K / BK; const int lda = g.lda, ldb = g.ldb;
    unsigned voffA[2], voffB[2];
#pragma unroll
    for (int i = 0; i < 2; ++i) { int R, C; stage_rc(tid * 16 + i * 8192, R, C); const int Rb = Epi::PERM ? ((R & ~31) + perm32(R & 31)) : R;
        voffA[i] = (unsigned)(R * lda + C) * 2u; voffB[i] = (unsigned)(Rb * ldb + C) * 2u; }
    const size_t kstep = (size_t)(BK * 2);
    const size_t hstepA = (size_t)HALF * lda * 2, hstepB = (size_t)HALF * ldb * 2;
    const size_t tstepA = 2 * hstepA, tstepB = 2 * hstepB; const size_t kslice = (size_t)K * 2;
    const unsigned ldsw = (unsigned)wid * 1024u;
    const int aoff = lds_byte(wr * 64 + fr, fq * 8), boff = lds_byte(wc * 32 + fr, fq * 8);
#define PG8_SA(b, h) (((b) * 2 + (h)) * HTB)
#define PG8_SB(b, h) ((4 + (b) * 2 + (h)) * HTB)
#define PG8_STAGE(bufoff, gbase, voff) do { _Pragma("unroll") for (int _i = 0; _i < 2; ++_i) \
        __builtin_amdgcn_global_load_lds((const unsigned*)((const char*)(gbase) + (voff)[_i]), (PG8_LAS unsigned*)(lds + (bufoff) + ldsw + _i * 8192), 16, 0, 0); } while (0)
#define PG8_LDA(dst, b, h) do { _Pragma("unroll") for (int m = 0; m < 4; ++m) _Pragma("unroll") for (int k = 0; k < 2; ++k) dst[m][k] = *(const PG8_LAS bf16x8*)(lds + PG8_SA(b, h) + aoff + m * 2048 + k * 1024); } while (0)
#define PG8_LDB(dst, b, h) do { _Pragma("unroll") for (int n = 0; n < 2; ++n) _Pragma("unroll") for (int k = 0; k < 2; ++k) dst[n][k] = *(const PG8_LAS bf16x8*)(lds + PG8_SB(b, h) + boff + n * 2048 + k * 1024); } while (0)
#define PG8_MMA(ai, bj, At, Bt) do { __builtin_amdgcn_s_setprio(1); _Pragma("unroll") for (int m = 0; m < 4; ++m) _Pragma("unroll") for (int n = 0; n < 2; ++n) _Pragma("unroll") for (int k = 0; k < 2; ++k) \
        acc[ai][bj][m][n] = __builtin_amdgcn_mfma_f32_16x16x32_bf16(Bt[n][k], At[m][k], acc[ai][bj][m][n], 0, 0, 0); __builtin_amdgcn_s_setprio(0); } while (0)
#define PG8_WAIT_V(n) asm volatile("s_waitcnt vmcnt(" #n ")" ::: "memory")
#define PG8_WAIT_L(n) asm volatile("s_waitcnt lgkmcnt(" #n ")" ::: "memory")
#define PG8_BAR __builtin_amdgcn_s_barrier()
#define PG8_SCHED __builtin_amdgcn_sched_barrier(0)
    Unit cur, nxt; int ui = 0;
    if (!S.next(0, cur)) return;
    f32x4 acc[2][2][4][2];
#pragma unroll
    for (int a = 0; a < 2; ++a)
#pragma unroll
        for (int b = 0; b < 2; ++b)
#pragma unroll
            for (int m = 0; m < 4; ++m)
#pragma unroll
                for (int n = 0; n < 2; ++n) acc[a][b][m][n] = (f32x4){0.f, 0.f, 0.f, 0.f};
    bf16x8 At[4][2], B0[2][2], B1[2][2];
    const char* cA = (const char*)g.A + (size_t)cur.pm * tstepA + (size_t)cur.pk * kslice; const char* cB = (const char*)g.Bt + (size_t)cur.pn * tstepB + (size_t)cur.pk * kslice;
    S.a_ready(cur);
    if constexpr (SP2) {
        PG8_STAGE(PG8_SB(0, 0), cB, voffB); PG8_STAGE(PG8_SB(0, 1), cB + hstepB, voffB); PG8_STAGE(PG8_SA(0, 0), cA, voffA); PG8_STAGE(PG8_SA(0, 1), cA + hstepA, voffA);
        if (wr == 1) PG8_BAR;
        PG8_WAIT_V(2); PG8_BAR;
        PG8_STAGE(PG8_SB(1, 0), cB + kstep, voffB); PG8_STAGE(PG8_SA(1, 0), cA + kstep, voffA); PG8_STAGE(PG8_SB(1, 1), cB + hstepB + kstep, voffB);
        PG8_WAIT_V(6); PG8_BAR;
    } else {
        PG8_STAGE(PG8_SB(0, 0), cB, voffB); PG8_STAGE(PG8_SA(0, 0), cA, voffA); PG8_STAGE(PG8_SB(0, 1), cB + hstepB, voffB); PG8_STAGE(PG8_SA(0, 1), cA + hstepA, voffA);
        if (wr == 1) PG8_BAR;
        PG8_WAIT_V(4); PG8_BAR;
        PG8_STAGE(PG8_SB(1, 0), cB + kstep, voffB); PG8_STAGE(PG8_SA(1, 0), cA + kstep, voffA); PG8_STAGE(PG8_SB(1, 1), cB + hstepB + kstep, voffB);
        PG8_WAIT_V(6); PG8_BAR;
    }
    for (;;) {
        const bool has_next = S.next(ui + 1, nxt);
        const char* nA = has_next ? (const char*)g.A + (size_t)nxt.pm * tstepA + (size_t)nxt.pk * kslice : cA; const char* nB = has_next ? (const char*)g.Bt + (size_t)nxt.pn * tstepB + (size_t)nxt.pk * kslice : cB;
        for (int t = 0; t < nt; t += 2) {
            const bool last = (t == nt - 2);
            const char* a1 = cA + (size_t)(t + 1) * kstep;
            const char* a2 = last ? nA : cA + (size_t)(t + 2) * kstep; const char* b2 = last ? nB : cB + (size_t)(t + 2) * kstep;
            const char* a3 = a2 + kstep; const char* b3 = b2 + kstep;
            if (last && has_next) S.a_ready(nxt);
            if constexpr (SP2) {
            PG8_LDB(B0, 0, 0); PG8_LDB(B1, 0, 1); PG8_SCHED; PG8_LDA(At, 0, 0); PG8_STAGE(PG8_SA(1, 1), a1 + hstepA, voffA);
            PG8_WAIT_V(8); PG8_WAIT_L(0); PG8_BAR; PG8_MMA(0, 0, At, B0); PG8_MMA(0, 1, At, B1); PG8_BAR; PG8_SCHED;
            PG8_LDA(At, 0, 1); PG8_STAGE(PG8_SB(0, 0), b2, voffB); PG8_STAGE(PG8_SB(0, 1), b2 + hstepB, voffB); PG8_STAGE(PG8_SA(0, 0), a2, voffA);
            PG8_WAIT_V(8); PG8_WAIT_L(0); PG8_BAR; PG8_MMA(1, 0, At, B0); PG8_MMA(1, 1, At, B1); PG8_BAR; PG8_SCHED;
            PG8_LDB(B0, 1, 0); PG8_LDB(B1, 1, 1); PG8_SCHED; PG8_LDA(At, 1, 0); PG8_STAGE(PG8_SA(0, 1), a2 + hstepA, voffA);
            PG8_WAIT_V(8); PG8_WAIT_L(0); PG8_BAR; PG8_MMA(0, 0, At, B0); PG8_MMA(0, 1, At, B1); PG8_BAR; PG8_SCHED;
            PG8_LDA(At, 1, 1); PG8_STAGE(PG8_SB(1, 0), b3, voffB); PG8_STAGE(PG8_SB(1, 1), b3 + hstepB, voffB); PG8_STAGE(PG8_SA(1, 0), a3, voffA);
            PG8_WAIT_V(8); PG8_WAIT_L(0); PG8_BAR; PG8_MMA(1, 0, At, B0); PG8_MMA(1, 1, At, B1); PG8_BAR; PG8_SCHED;
            } else {
            PG8_LDB(B0, 0, 0); PG8_SCHED; PG8_LDA(At, 0, 0); PG8_STAGE(PG8_SA(1, 1), a1 + hstepA, voffA);
            PG8_WAIT_L(8); PG8_BAR; PG8_WAIT_L(0); PG8_MMA(0, 0, At, B0); PG8_BAR; PG8_SCHED;
            PG8_LDB(B1, 0, 1); PG8_STAGE(PG8_SB(0, 0), b2, voffB);
            PG8_BAR; PG8_WAIT_L(0); PG8_MMA(0, 1, At, B1); PG8_BAR;
            PG8_LDA(At, 0, 1); PG8_STAGE(PG8_SA(0, 0), a2, voffA);
            PG8_BAR; PG8_WAIT_L(0); PG8_MMA(1, 0, At, B0); PG8_BAR; PG8_SCHED;
            PG8_STAGE(PG8_SB(0, 1), b2 + hstepB, voffB);
            PG8_WAIT_V(6); PG8_BAR; PG8_MMA(1, 1, At, B1); PG8_BAR;
            PG8_LDB(B0, 1, 0); PG8_SCHED; PG8_LDA(At, 1, 0); PG8_STAGE(PG8_SA(0, 1), a2 + hstepA, voffA);
            PG8_WAIT_L(8); PG8_BAR; PG8_WAIT_L(0); PG8_MMA(0, 0, At, B0); PG8_BAR; PG8_SCHED;
            PG8_LDB(B1, 1, 1); PG8_STAGE(PG8_SB(1, 0), b3, voffB);
            PG8_BAR; PG8_WAIT_L(0); PG8_MMA(0, 1, At, B1); PG8_BAR;
            PG8_LDA(At, 1, 1); PG8_STAGE(PG8_SA(1, 0), a3, voffA);
            PG8_BAR; PG8_WAIT_L(0); PG8_MMA(1, 0, At, B0); PG8_BAR; PG8_SCHED;
            PG8_STAGE(PG8_SB(1, 1), b3 + hstepB, voffB);
            PG8_WAIT_V(6); PG8_BAR; PG8_MMA(1, 1, At, B1); PG8_BAR;
            }
        }
        if constexpr (ALIGN_EPI) { if (wr == 0) PG8_BAR; }
        if constexpr (!Epi::AFTER_DRAIN) { E(acc, cur, wr, wc, fr, fq); S.done(cur); }
        if (!has_next) break;
#pragma unroll
        for (int a = 0; a < 2; ++a)
#pragma unroll
            for (int b = 0; b < 2; ++b)
#pragma unroll
                for (int m = 0; m < 4; ++m)
#pragma unroll
                    for (int n = 0; n < 2; ++n) acc[a][b][m][n] = (f32x4){0.f, 0.f, 0.f, 0.f};
        cur = nxt; cA = nA; cB = nB; ++ui;
        if constexpr (ALIGN_EPI) { if (wr == 1) PG8_BAR; }
    }
    PG8_WAIT_V(0);
    if constexpr (!ALIGN_EPI) { if (wr == 0) PG8_BAR; }
    PG8_BAR;
    if constexpr (Epi::AFTER_DRAIN) { E.fused(acc, cur, wr, wc, fr, fq, lds, wid, lane); S.done(cur); }
#undef PG8_SA
#undef PG8_SB
#undef PG8_STAGE
#undef PG8_LDA
#undef PG8_LDB
#undef PG8_MMA
#undef PG8_WAIT_V
#undef PG8_WAIT_L
#undef PG8_BAR
#undef PG8_SCHED
}
}
constexpr int NWAVES = 8, NTHR = 512;
constexpr int DM = 4096, DFF = 16384;
constexpr int PB = 2, PSEQ = 4096, NMETA = 16, PLEN = PSEQ + NMETA;
constexpr int SB = 128, ST = 4, PAST = 8192;
constexpr int MP = PB * PSEQ, MS = SB * ST, MM = MP + MS;
constexpr int META0 = MM, MVALID = MM + NMETA, MPAD = 8960;
constexpr int AH = 32, AKV = 8, AHD = 64, WIN = 128;
constexpr int BH = 16, BHD = 128, QB = 2048, CONVD = 6144;
constexpr int NIN_SRC = 19488, NINP = 19712, ZLD = 19456;
constexpr int ZC_QA = 0, ZC_KA = 2048, ZC_VA = 2560, ZC_QKVB = 3072, ZC_ZB = 9216, ZC_GA = 11264, ZC_GB = 15360;
constexpr float EPS = 1e-6f;
constexpr int NCH = 65, NUNIT_DN = PB * BH * NCH;
constexpr int NPOS = PLEN + ST;

constexpr size_t O_YP = 0, O_YS = O_YP + (size_t)MP * DM, O_WKP = O_YS + (size_t)MS * DM, O_WVP = O_WKP + (size_t)PB * WIN * 512, O_CP = O_WVP + (size_t)PB * WIN * 512,
                 O_DP = O_CP + (size_t)PB * 3 * CONVD, O_WKS = O_DP + (size_t)PB * BH * BHD * BHD, O_WVS = O_WKS + (size_t)SB * WIN * 512, O_CS = O_WVS + (size_t)SB * WIN * 512,
                 O_DS = O_CS + (size_t)SB * 3 * CONVD, O_END = O_DS + (size_t)SB * BH * BHD * BHD;
static_assert(O_END == 89165824, "d_out size");

constexpr size_t MiB = 1u << 20;
constexpr size_t WS_CTL = 0, CTL_ZERO_BYTES = 1 * MiB;
constexpr size_t WS_AB = 1 * MiB, WS_ROPE = 3 * MiB, WS_SQ1 = 4 * MiB, WS_SQ2 = 7 * MiB;
constexpr size_t WS_WA = 12 * MiB, WS_WB = 28 * MiB, WS_WOUT = 44 * MiB, WS_WUP = 76 * MiB, WS_WDN = 204 * MiB;
constexpr size_t WS_XN = 332 * MiB, WS_MERGED = WS_XN, WS_OA = 402 * MiB, WS_OB = 436 * MiB;
constexpr size_t WS_Z = 470 * MiB, WS_UACT = WS_Z;
constexpr size_t WS_WIN = 794 * MiB, WS_DN = WS_WIN, WS_RAW = WS_WIN, WS_END = 1084 * MiB;
constexpr size_t DN_AC = WS_DN, DN_BC = DN_AC + (size_t)NUNIT_DN * 32768, DN_QE = DN_BC + (size_t)NUNIT_DN * 32768, DN_OL = DN_QE + (size_t)NUNIT_DN * 16384, DN_ST = DN_OL + (size_t)NUNIT_DN * 16384;
static_assert(DN_ST + (size_t)NUNIT_DN * 32768 <= WS_END, "DeltaNet intermediates");
static_assert(WS_Z + (size_t)MVALID * ZLD * 2 <= WS_WIN && WS_UACT + (size_t)MM * DFF * 2 <= WS_WIN, "Z / UACT");
static_assert(WS_WIN + (size_t)NINP * DM * 2 <= WS_END && WS_RAW + (size_t)MM * DM * 4 <= WS_END, "W_IN_T / RAW");
static_assert(WS_XN + (size_t)MPAD * DM * 2 <= WS_OA && WS_OA + (size_t)MM * QB * 2 <= WS_OB && WS_OB + (size_t)MM * QB * 2 <= WS_Z, "XN / OA / OB");
constexpr size_t WS_PART = WS_OA;
constexpr int NSPLIT = 8, MFULL = MP, MTAIL = MS;
static_assert(WS_PART + (size_t)NSPLIT * MTAIL * DM * 4 <= WS_Z, "PART");
constexpr int CW_TMO = 0, CW_CODE = 1, CW_BAR = 4096;

constexpr int RING_OFF = 0, RING_BYTES = 131072;
constexpr int LDSCTL_OFF = 150528, MISC_OFF = LDSCTL_OFF + 320;
constexpr int LDS_BYTES = 151552;
static_assert(MISC_OFF + 128 <= LDS_BYTES, "LDS map");

#define GAS __attribute__((address_space(1)))
#define LAS __attribute__((address_space(3)))
#define DI __device__ __forceinline__
typedef unsigned short bf16;
typedef unsigned v4u __attribute__((ext_vector_type(4)));
typedef unsigned v2u __attribute__((ext_vector_type(2)));
typedef float f32x4 __attribute__((ext_vector_type(4)));
typedef float f32x16 __attribute__((ext_vector_type(16)));
typedef short bf16x8 __attribute__((ext_vector_type(8)));
typedef short s16x4 __attribute__((ext_vector_type(4)));
typedef GAS unsigned gu32;
#define RLX_AGENT __ATOMIC_RELAXED, __HIP_MEMORY_SCOPE_AGENT
#define LDS_WAIT() asm volatile("s_waitcnt lgkmcnt(0)" ::: "memory")
#define VM_WAIT() asm volatile("s_waitcnt vmcnt(0)" ::: "memory")
DI unsigned f2bf(float f) { unsigned u = __builtin_bit_cast(unsigned, f); return (u + 0x7fffu + ((u >> 16) & 1u)) >> 16; }
DI unsigned pk2(float lo, float hi) { return pg8::cvt_pk_bf16(lo, hi); }
DI float bf2f(bf16 b) { return __uint_as_float((unsigned)b << 16); }
DI float bflo(unsigned w) { return __uint_as_float(w << 16); }
DI float bfhi(unsigned w) { return __uint_as_float(w & 0xffff0000u); }
DI float sigm(float x) { return __builtin_amdgcn_rcpf(1.0f + __expf(-x)); }
DI float siluf(float x) { return x * sigm(x); }
DI float wave_sum(float v) {
#pragma unroll
    for (int o = 1; o < 64; o <<= 1) v += __shfl_xor(v, o);
    return v;
}
#define XB_TMO      128
#define XB_XCNT(j)  (256  + 64 * (j))
#define XB_XSUB(j)  (1280 + 64 * (j))
#define XB_XGEN(j)  (2304 + 64 * (j))
#define XB_TOP      3328
#define XB_TOPGEN   3392
#define XCD_BAR_WORDS 3456
#define XB_SPIN_CAP (1u << 18)

__device__ __forceinline__ unsigned xb_ld(unsigned* p)              { return __hip_atomic_load(p, __ATOMIC_RELAXED, __HIP_MEMORY_SCOPE_AGENT); }
__device__ __forceinline__ unsigned xb_add(unsigned* p, unsigned v) { return __hip_atomic_fetch_add(p, v, __ATOMIC_RELAXED, __HIP_MEMORY_SCOPE_AGENT); }
__device__ __forceinline__ unsigned xb_xcc_id() { return (unsigned)__builtin_amdgcn_s_getreg((3 << 11) | 20) & 0xFu; }
#define XB_SPIN(cond, bar) do { unsigned _sp = 0; while (cond) { __builtin_amdgcn_s_sleep(1); \
    if ((++_sp & 255u) == 0u) { if (xb_ld(&(bar)[XB_TMO])) break; if (_sp > XB_SPIN_CAP) { atomicAdd(&(bar)[XB_TMO], 1u); break; } } } } while (0)

struct XcdBarrier {
    unsigned* bar; unsigned x;
    volatile LAS unsigned* st;
};

__device__ __forceinline__ XcdBarrier xcd_barrier_post(unsigned* bar, volatile LAS unsigned* st) {
    XcdBarrier b; b.bar = bar; b.x = xb_xcc_id(); b.st = st;
    if (threadIdx.x == 0) (void)xb_add(&bar[XB_XCNT(b.x)], 1u);
    return b;
}
__device__ __forceinline__ void xcd_barrier_complete(unsigned* bar, unsigned x, unsigned& nloc, unsigned& nx) {
    const unsigned G = gridDim.x * gridDim.y * gridDim.z;
    unsigned sum, cnt, mine, sp = 0u;
    for (;;) {
        sum = 0u; cnt = 0u; mine = 0u;
#pragma unroll
        for (unsigned j = 0; j < 16; ++j) { const unsigned c = xb_ld(&bar[XB_XCNT(j)]); sum += c; cnt += (c > 0u) ? 1u : 0u; mine = (j == x) ? c : mine; }
        if (sum == G) break;
        __builtin_amdgcn_s_sleep(1);
        if ((++sp & 255u) == 0u) { if (xb_ld(&bar[XB_TMO])) break; if (sp > XB_SPIN_CAP) { atomicAdd(&bar[XB_TMO], 1u); break; } }
    }
    nloc = mine > 0u ? mine : 1u; nx = cnt > 0u ? cnt : 1u;
}

__device__ __forceinline__ void xcd_barrier(const XcdBarrier& b) {
    asm volatile("s_waitcnt vmcnt(0)" ::: "memory");
    __syncthreads();
    if (threadIdx.x == 0) {
        unsigned* bar = b.bar;
        __builtin_amdgcn_s_waitcnt(0);
        unsigned nloc = b.st[0], nx = b.st[1];
        if (nloc == 0u) { xcd_barrier_complete(bar, b.x, nloc, nx); b.st[0] = nloc; b.st[1] = nx; }
        const unsigned old = xb_add(&bar[XB_XSUB(b.x)], 1u);
        const unsigned gen = old / nloc;
        if (old + 1u == (gen + 1u) * nloc) {
            __builtin_amdgcn_fence(__ATOMIC_RELEASE, "agent");
            asm volatile("s_waitcnt vmcnt(0)" ::: "memory");
            const unsigned og = xb_add(&bar[XB_TOP], 1u);
            const unsigned tg = og / nx;
            if (og + 1u == (tg + 1u) * nx) xb_add(&bar[XB_TOPGEN], 1u);
            else XB_SPIN(xb_ld(&bar[XB_TOPGEN]) == tg, bar);
            __builtin_amdgcn_fence(__ATOMIC_ACQUIRE, "agent");
            xb_add(&bar[XB_XGEN(b.x)], 1u);
            asm volatile("s_waitcnt vmcnt(0)" ::: "memory");
        } else {
            XB_SPIN(xb_ld(&bar[XB_XGEN(b.x)]) == gen, bar);
            __builtin_amdgcn_fence(__ATOMIC_ACQUIRE, "agent");
            asm volatile("s_waitcnt vmcnt(0)" ::: "memory");
        }
    }
    __syncthreads();
}

struct Args { const float* in[22]; float* out; unsigned char* ws; int ph_lo, ph_hi; };
enum { I_XP = 0, I_XS, I_CK, I_CV, I_SCONV, I_SDELTA, I_META, I_NMIXPRE, I_NMIXPOST, I_NMLPPRE, I_NMLPPOST, I_WIN, I_SINKS, I_CONVW, I_ALOG, I_DTB, I_DNORM, I_WA, I_WB, I_WOUT, I_WUP, I_WDN };

DI void p0_transpose_item(const float* W, int K, int ldn, bf16* WT, int k0, int n0, int drow, int drow2, LAS float* scr, int lane) {
    const int rr = lane >> 4, c4 = lane & 15;
    f32x4 v[16];
#pragma unroll
    for (int i = 0; i < 16; ++i) v[i] = __builtin_nontemporal_load((const GAS f32x4*)(W + (size_t)(k0 + 4 * i + rr) * ldn + n0) + c4);
#pragma unroll
    for (int i = 0; i < 16; ++i) { LAS float* d = scr + (4 * i + rr) * 65 + 4 * c4; d[0] = v[i].x; d[1] = v[i].y; d[2] = v[i].z; d[3] = v[i].w; }
    LDS_WAIT(); asm volatile("" ::: "memory");
    const int c = lane & 7;
#pragma unroll
    for (int j = 0; j < 8; ++j) { const int n = (lane >> 3) + 8 * j; const LAS float* s = scr + (8 * c) * 65 + n;
        v4u o; o.x = pk2(s[0 * 65], s[1 * 65]); o.y = pk2(s[2 * 65], s[3 * 65]); o.z = pk2(s[4 * 65], s[5 * 65]); o.w = pk2(s[6 * 65], s[7 * 65]);
        const int dr = n < 32 ? drow + n : drow2 + n - 32;
        *(GAS v4u*)(WT + (size_t)dr * K + k0 + 8 * c) = o; }
    LDS_WAIT(); asm volatile("" ::: "memory");
}
DI void p0_transpose_item_half(const float* W, int K, int ldn, bf16* WT, int k0, int n0, int drow, LAS float* scr, int lane) {
#pragma unroll 8
    for (int i = 0; i < 32; ++i) { const int kk = 2 * i + (lane >> 5); scr[kk * 33 + (lane & 31)] = W[(size_t)(k0 + kk) * ldn + n0 + (lane & 31)]; }
    LDS_WAIT(); asm volatile("" ::: "memory");
    const int c = lane & 7;
#pragma unroll
    for (int j = 0; j < 4; ++j) { const int n = (lane >> 3) + 8 * j; const LAS float* s = scr + (8 * c) * 33 + n;
        v4u o; o.x = pk2(s[0 * 33], s[1 * 33]); o.y = pk2(s[2 * 33], s[3 * 33]); o.z = pk2(s[4 * 33], s[5 * 33]); o.w = pk2(s[6 * 33], s[7 * 33]);
        *(GAS v4u*)(WT + (size_t)(drow + n) * K + k0 + 8 * c) = o; }
    LDS_WAIT(); asm volatile("" ::: "memory");
}
DI void rms_row_to_bf16(const float* xrow, const float* w, bf16* orow, int lane) {
    const GAS f32x4* xr = (const GAS f32x4*)xrow + lane; const GAS f32x4* wr = (const GAS f32x4*)w + lane;
    f32x4 v[16]; float s = 0.f;
#pragma unroll
    for (int j = 0; j < 16; ++j) { v[j] = xr[64 * j]; s += (v[j].x * v[j].x + v[j].y * v[j].y) + (v[j].z * v[j].z + v[j].w * v[j].w); }
    const float rstd = 1.f / sqrtf(wave_sum(s) * (1.f / DM) + EPS);
    GAS v2u* o8 = (GAS v2u*)orow + lane;
#pragma unroll
    for (int j = 0; j < 16; ++j) { const f32x4 g = wr[64 * j]; v2u o; o.x = pk2(v[j].x * rstd * g.x, v[j].y * rstd * g.y); o.y = pk2(v[j].z * rstd * g.z, v[j].w * rstd * g.w); o8[64 * j] = o; }
}
DI const float* h_row(const Args& a, int m) {
    return m < MP ? a.in[I_XP] + (size_t)m * DM : (m < MM ? a.in[I_XS] + (size_t)(m - MP) * DM : a.in[I_META] + (size_t)(m - MM) * DM);
}
DI void p0_prologue(const Args& a, LAS unsigned char* lds, int wave, int lane) {
    LAS float* scr = (LAS float*)(lds + wave * 16640);
    const int gw = blockIdx.x * NWAVES + wave, NGW = gridDim.x * NWAVES;
    unsigned char* ws = a.ws;
    constexpr int NB_IN = (NIN_SRC + 63) / 64;
    constexpr int I_IN = (DM / 64) * NB_IN, I_A = (QB / 64) * (DM / 64), I_O = (DM / 64) * (DM / 64), I_U = (DM / 64) * (DFF / 64), I_D = (DFF / 64) * (DM / 64);
    constexpr int NITEMS = I_IN + 2 * I_A + I_O + I_U + I_D;
    for (int it = gw; it < NITEMS; it += NGW) {
        int r = it;
        if (r < I_IN) { const int kb = r / NB_IN, nb = r % NB_IN, n0 = 64 * nb;
            int d1, d2; if (n0 < 11264) { d1 = n0; d2 = n0 + 32; } else if (n0 == 11264) { d1 = ZLD; d2 = 11264; } else { d1 = n0 - 32; d2 = n0; }
            if (nb == NB_IN - 1) { p0_transpose_item_half(a.in[I_WIN], DM, NIN_SRC, (bf16*)(ws + WS_WIN), 64 * kb, n0, d1, scr, lane); }
            else p0_transpose_item(a.in[I_WIN], DM, NIN_SRC, (bf16*)(ws + WS_WIN), 64 * kb, n0, d1, d2, scr, lane);
            continue; } r -= I_IN;
        if (r < I_A) { const int nblk = DM / 64; p0_transpose_item(a.in[I_WA], QB, DM, (bf16*)(ws + WS_WA), 64 * (r / nblk), 64 * (r % nblk), 64 * (r % nblk), 64 * (r % nblk) + 32, scr, lane); continue; } r -= I_A;
        if (r < I_A) { const int nblk = DM / 64; p0_transpose_item(a.in[I_WB], QB, DM, (bf16*)(ws + WS_WB), 64 * (r / nblk), 64 * (r % nblk), 64 * (r % nblk), 64 * (r % nblk) + 32, scr, lane); continue; } r -= I_A;
        if (r < I_O) { const int nblk = DM / 64; p0_transpose_item(a.in[I_WOUT], DM, DM, (bf16*)(ws + WS_WOUT), 64 * (r / nblk), 64 * (r % nblk), 64 * (r % nblk), 64 * (r % nblk) + 32, scr, lane); continue; } r -= I_O;
        if (r < I_U) { const int nblk = DFF / 64; p0_transpose_item(a.in[I_WUP], DM, DFF, (bf16*)(ws + WS_WUP), 64 * (r / nblk), 64 * (r % nblk), 64 * (r % nblk), 64 * (r % nblk) + 32, scr, lane); continue; } r -= I_U;
        { const int nblk = DM / 64; p0_transpose_item(a.in[I_WDN], DFF, DM, (bf16*)(ws + WS_WDN), 64 * (r / nblk), 64 * (r % nblk), 64 * (r % nblk), 64 * (r % nblk) + 32, scr, lane); }
    }
    bf16* XN = (bf16*)(ws + WS_XN);
    for (int m = gw; m < MPAD; m += NGW) {
        if (m < MVALID) rms_row_to_bf16(h_row(a, m), a.in[I_NMIXPRE], XN + (size_t)m * DM, lane);
        else { GAS v4u* o = (GAS v4u*)(XN + (size_t)m * DM) + lane;
#pragma unroll
            for (int j = 0; j < 8; ++j) o[64 * j] = (v4u){0u, 0u, 0u, 0u}; }
    }
    float* rope = (float*)(ws + WS_ROPE);
    for (int e = blockIdx.x * NTHR + threadIdx.x; e < NPOS * 8; e += gridDim.x * NTHR) {
        const int pi = e >> 3, i = e & 7; const float pos = (float)(pi < PLEN ? pi : PAST + (pi - PLEN));
        const float inv = __builtin_amdgcn_exp2f(-(float)i * 2.3664460711655218f);
        const float ang = pos * inv; const float rev = ang * 0.15915494309189535f; const float fr = rev - floorf(rev); const float sn = __builtin_amdgcn_sinf(fr), cs = __builtin_amdgcn_cosf(fr);
        rope[2 * e] = cs; rope[2 * e + 1] = sn;
    }
}

DI float rope_k(const bf16* zrow, const float* rope, int pi, int h, int d) {
    const bf16* kp = zrow + ZC_KA + h * AHD;
    if (d >= 16) return bf2f(kp[d]);
    const int i = d & 7; const float x1 = bf2f(kp[i]), x2 = bf2f(kp[8 + i]); const float cs = rope[(pi * 8 + i) * 2], sn = rope[(pi * 8 + i) * 2 + 1];
    return d < 8 ? x1 * cs - x2 * sn : x2 * cs + x1 * sn;
}
DI void p2_state_outputs(const Args& a) {
    const bf16* Z = (const bf16*)(a.ws + WS_Z); const float* rope = (const float*)(a.ws + WS_ROPE); float* out = a.out;
    const int gt = blockIdx.x * NTHR + threadIdx.x, NT = gridDim.x * NTHR;
    for (int e = gt; e < PB * WIN * 512; e += NT) {
        const int d = e & 63, h = (e >> 6) & 7, j = (e >> 9) & 127, b = e >> 16; const int t = PSEQ - WIN + j; const bf16* zr = Z + (size_t)(b * PSEQ + t) * ZLD;
        out[O_WKP + e] = rope_k(zr, rope, t + NMETA, h, d); out[O_WVP + e] = bf2f(zr[ZC_VA + h * AHD + d]);
    }
    for (int e = gt; e < PB * 3 * CONVD; e += NT) {
        const int c = e % CONVD, j = (e / CONVD) % 3, b = e / (3 * CONVD); out[O_CP + e] = bf2f(Z[(size_t)(b * PSEQ + PSEQ - 3 + j) * ZLD + ZC_QKVB + c]);
    }
    for (int e = gt; e < SB * WIN * 512; e += NT) {
        const int d = e & 63, h = (e >> 6) & 7, j = (e >> 9) & 127, b = e >> 16;
        if (j < WIN - ST) { const size_t src = ((size_t)b * WIN + j + ST) * 512 + h * 64 + d; out[O_WKS + e] = a.in[I_CK][src]; out[O_WVS + e] = a.in[I_CV][src]; }
        else { const int t = j - (WIN - ST); const bf16* zr = Z + (size_t)(MP + b * ST + t) * ZLD; out[O_WKS + e] = rope_k(zr, rope, PLEN + t, h, d); out[O_WVS + e] = bf2f(zr[ZC_VA + h * AHD + d]); }
    }
    for (int e = gt; e < SB * 3 * CONVD; e += NT) {
        const int c = e % CONVD, j = (e / CONVD) % 3, b = e / (3 * CONVD); out[O_CS + e] = bf2f(Z[(size_t)(MP + b * ST + 1 + j) * ZLD + ZC_QKVB + c]);
    }
}

#define MFMA16(a, b, c) __builtin_amdgcn_mfma_f32_16x16x32_bf16((a), (b), (c), 0, 0, 0)
#define MFMA32(a, b, c) __builtin_amdgcn_mfma_f32_32x32x16_bf16((a), (b), (c), 0, 0, 0)
DI int crow(int r, int hi) { return (r & 3) + 8 * (r >> 2) + 4 * hi; }
DI bf16x8 pack8(float a0, float a1, float a2, float a3, float a4, float a5, float a6, float a7) {
    v4u p; p.x = pk2(a0, a1); p.y = pk2(a2, a3); p.z = pk2(a4, a5); p.w = pk2(a6, a7); return __builtin_bit_cast(bf16x8, p);
}
template <int KS> DI f32x4 mm_lds(const LAS bf16* X, int ldx, int xrow0, const LAS bf16* Y, int ldy, int yrow0, int r, int q) {
    f32x4 acc = {0.f, 0.f, 0.f, 0.f};
    const LAS bf16* xp = X + (xrow0 + r) * ldx + 8 * q; const LAS bf16* yp = Y + (yrow0 + r) * ldy + 8 * q;
#pragma unroll
    for (int ks = 0; ks < KS; ++ks) { const bf16x8 xa = *(const LAS bf16x8*)(xp + 32 * ks); const bf16x8 yb = *(const LAS bf16x8*)(yp + 32 * ks); acc = MFMA16(xa, yb, acc); }
    return acc;
}

constexpr int AT_KS = 0, AT_VT = 27648, AT_KP = 72, AT_VP = 200;
constexpr int N_ATT_P = PB * AKV * (PSEQ / 64);
DI int zrow_of(int b, int tk) { return tk >= 0 ? b * PSEQ + tk : MVALID + tk; }
DI void attn_prompt_unit(const Args& a, LAS unsigned char* lds, int unit, int tid, int wave, int lane) {
    const bf16* Z = (const bf16*)(a.ws + WS_Z); const float* rope = (const float*)(a.ws + WS_ROPE); bf16* OA = (bf16*)(a.ws + WS_OA);
    const int qb = unit & 63, kvh = (unit >> 6) & 7, b = unit >> 9; const int t0 = qb * 64;
    LAS bf16* Ks = (LAS bf16*)(lds + AT_KS); LAS bf16* Vt = (LAS bf16*)(lds + AT_VT);
    for (int task = tid; task < 192 * 4; task += NTHR) {
        const int j = task >> 2, cp = task & 3; const int tk = t0 - 128 + j; v4u lo = {0u, 0u, 0u, 0u}, hi4 = {0u, 0u, 0u, 0u};
        if (tk >= -NMETA) { const bf16* src = Z + (size_t)zrow_of(b, tk) * ZLD + ZC_KA + kvh * AHD + 16 * cp; lo = *(const GAS v4u*)src; hi4 = *(const GAS v4u*)(src + 8);
            if (cp == 0) { const float* rp = rope + (size_t)(tk + NMETA) * 16; float x1[8], x2[8], o1[8], o2[8];
                x1[0] = bflo(lo.x); x1[1] = bfhi(lo.x); x1[2] = bflo(lo.y); x1[3] = bfhi(lo.y); x1[4] = bflo(lo.z); x1[5] = bfhi(lo.z); x1[6] = bflo(lo.w); x1[7] = bfhi(lo.w);
                x2[0] = bflo(hi4.x); x2[1] = bfhi(hi4.x); x2[2] = bflo(hi4.y); x2[3] = bfhi(hi4.y); x2[4] = bflo(hi4.z); x2[5] = bfhi(hi4.z); x2[6] = bflo(hi4.w); x2[7] = bfhi(hi4.w);
#pragma unroll
                for (int i = 0; i < 8; ++i) { const float cs = rp[2 * i], sn = rp[2 * i + 1]; o1[i] = x1[i] * cs - x2[i] * sn; o2[i] = x2[i] * cs + x1[i] * sn; }
                lo.x = pk2(o1[0], o1[1]); lo.y = pk2(o1[2], o1[3]); lo.z = pk2(o1[4], o1[5]); lo.w = pk2(o1[6], o1[7]);
                hi4.x = pk2(o2[0], o2[1]); hi4.y = pk2(o2[2], o2[3]); hi4.z = pk2(o2[4], o2[5]); hi4.w = pk2(o2[6], o2[7]); } }
        *(LAS v4u*)(Ks + j * AT_KP + 16 * cp) = lo; *(LAS v4u*)(Ks + j * AT_KP + 16 * cp + 8) = hi4;
    }
    for (int task = tid; task < 192 * 8; task += NTHR) {
        const int j = task >> 3, c8 = task & 7; const int tk = t0 - 128 + j; v4u v = {0u, 0u, 0u, 0u};
        if (tk >= -NMETA) v = *(const GAS v4u*)(Z + (size_t)zrow_of(b, tk) * ZLD + ZC_VA + kvh * AHD + 8 * c8);
        LAS bf16* vp = Vt + (8 * c8) * AT_VP + j;
        vp[0 * AT_VP] = (bf16)(v.x & 0xffffu); vp[1 * AT_VP] = (bf16)(v.x >> 16); vp[2 * AT_VP] = (bf16)(v.y & 0xffffu); vp[3 * AT_VP] = (bf16)(v.y >> 16);
        vp[4 * AT_VP] = (bf16)(v.z & 0xffffu); vp[5 * AT_VP] = (bf16)(v.z >> 16); vp[6 * AT_VP] = (bf16)(v.w & 0xffffu); vp[7 * AT_VP] = (bf16)(v.w >> 16);
    }
    const int r32 = lane & 31, hi = lane >> 5; const int g = wave >> 1, wq = wave & 1; const int hq = kvh * 4 + g; const int tq = t0 + 32 * wq + r32;
    const bf16* qsrc = Z + (size_t)(b * PSEQ + tq) * ZLD + ZC_QA + hq * AHD;
    bf16x8 qf[4];
    { const v4u lo = *(const GAS v4u*)qsrc, h4 = *(const GAS v4u*)(qsrc + 8); const float* rp = rope + (size_t)(tq + NMETA) * 16; float x1[8], x2[8], o[8];
      x1[0] = bflo(lo.x); x1[1] = bfhi(lo.x); x1[2] = bflo(lo.y); x1[3] = bfhi(lo.y); x1[4] = bflo(lo.z); x1[5] = bfhi(lo.z); x1[6] = bflo(lo.w); x1[7] = bfhi(lo.w);
      x2[0] = bflo(h4.x); x2[1] = bfhi(h4.x); x2[2] = bflo(h4.y); x2[3] = bfhi(h4.y); x2[4] = bflo(h4.z); x2[5] = bfhi(h4.z); x2[6] = bflo(h4.w); x2[7] = bfhi(h4.w);
#pragma unroll
      for (int i = 0; i < 8; ++i) { const float cs = rp[2 * i], sn = rp[2 * i + 1]; o[i] = hi == 0 ? x1[i] * cs - x2[i] * sn : x2[i] * cs + x1[i] * sn; }
      qf[0] = pack8(o[0], o[1], o[2], o[3], o[4], o[5], o[6], o[7]); }
#pragma unroll
    for (int ks = 1; ks < 4; ++ks) qf[ks] = __builtin_bit_cast(bf16x8, *(const GAS v4u*)(qsrc + 16 * ks + 8 * hi));
    LDS_WAIT(); __syncthreads();
    f32x16 s[5];
#pragma unroll
    for (int kb = 0; kb < 5; ++kb) { f32x16 acc = {};
        const LAS bf16* kp = Ks + (32 * (wq + kb) + r32) * AT_KP + 8 * hi;
#pragma unroll
        for (int ks = 0; ks < 4; ++ks) { const bf16x8 kf = *(const LAS bf16x8*)(kp + 16 * ks); acc = MFMA32(kf, qf[ks], acc); }
        s[kb] = acc; }
    const float C2 = 0.125f * 1.4426950408889634f; const float sink2 = a.in[I_SINKS][hq] * 1.4426950408889634f;
    float mx = sink2;
#pragma unroll
    for (int kb = 0; kb < 5; ++kb)
#pragma unroll
        for (int r = 0; r < 16; ++r) { const int jp = 32 * kb + crow(r, hi); const int tk = t0 - 128 + 32 * wq + jp;
            const bool ok = (jp >= r32) && (jp <= 128 + r32) && (tk >= -NMETA); const float v = ok ? s[kb][r] * C2 : -INFINITY; s[kb][r] = v; mx = fmaxf(mx, v); }
    mx = fmaxf(mx, __shfl_xor(mx, 32));
    float l = 0.f;
#pragma unroll
    for (int kb = 0; kb < 5; ++kb)
#pragma unroll
        for (int r = 0; r < 16; ++r) { const float p = exp2f(s[kb][r] - mx); s[kb][r] = p; l += p; }
    l += __shfl_xor(l, 32); l += exp2f(sink2 - mx);
    const float rl = 1.0f / l;
    f32x16 o[2]; o[0] = (f32x16){}; o[1] = (f32x16){};
#pragma unroll
    for (int kb = 0; kb < 5; ++kb)
#pragma unroll
        for (int st = 0; st < 2; ++st) {
            const bf16x8 pf = pack8(s[kb][8 * st + 0], s[kb][8 * st + 1], s[kb][8 * st + 2], s[kb][8 * st + 3], s[kb][8 * st + 4], s[kb][8 * st + 5], s[kb][8 * st + 6], s[kb][8 * st + 7]);
#pragma unroll
            for (int db = 0; db < 2; ++db) { const LAS bf16* vp = Vt + (32 * db + r32) * AT_VP + 32 * (wq + kb) + 16 * st + 4 * hi;
                const s16x4 v0 = *(const LAS s16x4*)vp, v1 = *(const LAS s16x4*)(vp + 8);
                const bf16x8 vf = __builtin_shufflevector(v0, v1, 0, 1, 2, 3, 4, 5, 6, 7);
                o[db] = MFMA32(vf, pf, o[db]); } }
    bf16* orow = OA + (size_t)(b * PSEQ + tq) * QB + hq * AHD;
#pragma unroll
    for (int db = 0; db < 2; ++db)
#pragma unroll
        for (int g4 = 0; g4 < 4; ++g4) { v2u w; w.x = pk2(o[db][4 * g4] * rl, o[db][4 * g4 + 1] * rl); w.y = pk2(o[db][4 * g4 + 2] * rl, o[db][4 * g4 + 3] * rl);
            *(GAS v2u*)(orow + 32 * db + 8 * g4 + 4 * hi) = w; }
    __syncthreads();
}

constexpr int AS_K = 0, AS_V = 34320, AS_Q = 68640, AS_P = 72736;
constexpr int N_ATT_S = SB * AKV;
DI void attn_sample_unit(const Args& a, LAS unsigned char* lds, int unit, int tid, int wave, int lane) {
    const bf16* Z = (const bf16*)(a.ws + WS_Z); const float* rope = (const float*)(a.ws + WS_ROPE); bf16* OA = (bf16*)(a.ws + WS_OA);
    const int kvh = unit & 7, b = unit >> 3;
    LAS float* Kf = (LAS float*)(lds + AS_K); LAS float* Vf = (LAS float*)(lds + AS_V); LAS float* Qf = (LAS float*)(lds + AS_Q); LAS float* Pf = (LAS float*)(lds + AS_P);
    for (int e = tid; e < 128 * 64; e += NTHR) { const int k = e >> 6, d = e & 63; const size_t src = ((size_t)b * WIN + k) * 512 + kvh * 64 + d; Kf[k * 65 + d] = a.in[I_CK][src]; Vf[k * 65 + d] = a.in[I_CV][src]; }
    if (tid < 256) { const int t = tid >> 6, d = tid & 63; const bf16* zr = Z + (size_t)(MP + b * ST + t) * ZLD; Kf[(128 + t) * 65 + d] = rope_k(zr, rope, PLEN + t, kvh, d); Vf[(128 + t) * 65 + d] = bf2f(zr[ZC_VA + kvh * AHD + d]); }
    for (int e = tid; e < 16 * 64; e += NTHR) { const int rr = e >> 6, d = e & 63; const int t = rr >> 2, g = rr & 3; const bf16* qp = Z + (size_t)(MP + b * ST + t) * ZLD + ZC_QA + (kvh * 4 + g) * AHD; float v;
        if (d >= 16) v = bf2f(qp[d]); else { const int i = d & 7; const float x1 = bf2f(qp[i]), x2 = bf2f(qp[8 + i]); const float cs = rope[((PLEN + t) * 8 + i) * 2], sn = rope[((PLEN + t) * 8 + i) * 2 + 1]; v = d < 8 ? x1 * cs - x2 * sn : x2 * cs + x1 * sn; }
        Qf[rr * 64 + d] = v; }
    LDS_WAIT(); __syncthreads();
    for (int p = tid; p < 16 * 132; p += NTHR) { const int rr = p / 132, k = p % 132; const int t = rr >> 2; float acc = 0.f;
#pragma unroll 16
        for (int d = 0; d < 64; ++d) acc += Qf[rr * 64 + d] * Kf[k * 65 + d];
        const bool ok = k < 128 ? (k >= t) : (k - 128 <= t); Pf[rr * 132 + k] = ok ? acc * 0.125f : -INFINITY; }
    LDS_WAIT(); __syncthreads();
#pragma unroll
    for (int i = 0; i < 2; ++i) { const int rr = wave * 2 + i; const int g = rr & 3; const float sk = a.in[I_SINKS][kvh * 4 + g];
        float v0 = Pf[rr * 132 + lane], v1 = Pf[rr * 132 + 64 + lane], v2 = lane < 4 ? Pf[rr * 132 + 128 + lane] : -INFINITY;
        float m = fmaxf(fmaxf(v0, v1), fmaxf(v2, sk));
#pragma unroll
        for (int o = 1; o < 64; o <<= 1) m = fmaxf(m, __shfl_xor(m, o));
        const float p0 = __expf(v0 - m), p1 = __expf(v1 - m), p2 = lane < 4 ? __expf(v2 - m) : 0.f; const float l = wave_sum(p0 + p1 + p2) + __expf(sk - m); const float rl = 1.0f / l;
        Pf[rr * 132 + lane] = p0 * rl; Pf[rr * 132 + 64 + lane] = p1 * rl; if (lane < 4) Pf[rr * 132 + 128 + lane] = p2 * rl; }
    LDS_WAIT(); __syncthreads();
    for (int e = tid; e < 16 * 64; e += NTHR) { const int rr = e >> 6, d = e & 63; const int t = rr >> 2, g = rr & 3; float acc = 0.f;
#pragma unroll 4
        for (int k = 0; k < 132; ++k) acc += Pf[rr * 132 + k] * Vf[k * 65 + d];
        OA[(size_t)(MP + b * ST + t) * QB + (kvh * 4 + g) * AHD + d] = (bf16)f2bf(acc); }
    LDS_WAIT(); __syncthreads();
}

DI float softplusf_(float x) { const float t = __expf(-fabsf(x)); return fmaxf(x, 0.f) + (t < 1e-3f ? t * (1.0f - 0.5f * t) : __logf(1.0f + t)); }
constexpr int N_DN_S = SB * BH;
DI void dn_sample_unit(const Args& a, LAS unsigned char* lds, int unit, int tid, int wave, int lane) {
    const bf16* Z = (const bf16*)(a.ws + WS_Z); const float* AB = (const float*)(a.ws + WS_AB); bf16* OB = (bf16*)(a.ws + WS_OB);
    const int h = unit & 15, b = unit >> 4;
    LAS float* raw = (LAS float*)lds; LAS float* red = (LAS float*)(lds + 6144); LAS float* os = (LAS float*)(lds + 10240); LAS float* gb = (LAS float*)(lds + 12288);
    if (tid < 384) { const int which = tid >> 7, dd = tid & 127; const int c = which * QB + h * BHD + dd; float xx[7];
#pragma unroll
        for (int j = 0; j < 3; ++j) xx[j] = a.in[I_SCONV][((size_t)b * 3 + j) * CONVD + c];
#pragma unroll
        for (int t = 0; t < 4; ++t) xx[3 + t] = bf2f(Z[(size_t)(MP + b * ST + t) * ZLD + ZC_QKVB + c]);
        float w[4];
#pragma unroll
        for (int j = 0; j < 4; ++j) w[j] = a.in[I_CONVW][(size_t)j * CONVD + c];
#pragma unroll
        for (int t = 0; t < 4; ++t) { const float y = xx[t] * w[0] + xx[t + 1] * w[1] + xx[t + 2] * w[2] + xx[t + 3] * w[3]; raw[(which * 4 + t) * 128 + dd] = siluf(y); }
    } else if (tid < 388) { const int t = tid - 384; const int row = MP + b * ST + t; const float braw = AB[(size_t)row * 32 + h], araw = AB[(size_t)row * 32 + 16 + h];
        gb[t] = __expf(-__expf(a.in[I_ALOG][h]) * softplusf_(araw + a.in[I_DTB][h])); gb[4 + t] = sigm(braw); }
    LDS_WAIT(); __syncthreads();
    { const int which = wave >> 2, t = wave & 3; LAS float* v = raw + (which * 4 + t) * 128; const float x0 = v[lane], x1 = v[64 + lane]; const float ss = wave_sum(x0 * x0 + x1 * x1);
      const float sc = (1.0f / sqrtf(ss + EPS)) * (which == 0 ? 0.08838834764831845f : 1.0f); v[lane] = x0 * sc; v[64 + lane] = x1 * sc; }
    const int e = tid & 127, dg = tid >> 7;
    float S[32];
    const float* sp = a.in[I_SDELTA] + ((size_t)unit * BHD + 32 * dg) * BHD + e;
#pragma unroll
    for (int i = 0; i < 32; ++i) S[i] = sp[(size_t)i * BHD];
    LDS_WAIT(); __syncthreads();
    const LAS float* qs = raw; const LAS float* ks = raw + 512; const LAS float* vs = raw + 1024;
#pragma unroll
    for (int t = 0; t < 4; ++t) {
        const float eg = gb[t], beta = gb[4 + t]; float part = 0.f;
#pragma unroll
        for (int i = 0; i < 32; ++i) part += ks[t * 128 + 32 * dg + i] * S[i];
        red[dg * 128 + e] = part; LDS_WAIT(); __syncthreads();
        const float kS = eg * ((red[e] + red[128 + e]) + (red[256 + e] + red[384 + e])); const float vn = beta * (vs[t * 128 + e] - kS); float p2 = 0.f;
#pragma unroll
        for (int i = 0; i < 32; ++i) { S[i] = eg * S[i] + ks[t * 128 + 32 * dg + i] * vn; p2 += qs[t * 128 + 32 * dg + i] * S[i]; }
        red[512 + dg * 128 + e] = p2; LDS_WAIT(); __syncthreads();
        if (dg == 0) os[t * 128 + e] = (red[512 + e] + red[640 + e]) + (red[768 + e] + red[896 + e]);
    }
    float* dp = a.out + O_DS + ((size_t)unit * BHD + 32 * dg) * BHD + e;
#pragma unroll
    for (int i = 0; i < 32; ++i) dp[(size_t)i * BHD] = S[i];
    LDS_WAIT(); __syncthreads();
    if (wave < 4) { const int t = wave; const int row = MP + b * ST + t; const float o0 = os[t * 128 + lane], o1 = os[t * 128 + 64 + lane]; const float rstd = 1.0f / sqrtf(wave_sum(o0 * o0 + o1 * o1) * (1.0f / 128.0f) + EPS);
        const bf16* zp = Z + (size_t)row * ZLD + ZC_ZB + h * BHD; const float z0 = bf2f(zp[lane]), z1 = bf2f(zp[64 + lane]);
        bf16* op = OB + (size_t)row * QB + h * BHD; op[lane] = (bf16)f2bf(o0 * rstd * a.in[I_DNORM][lane] * siluf(z0)); op[64 + lane] = (bf16)f2bf(o1 * rstd * a.in[I_DNORM][64 + lane] * siluf(z1)); }
    LDS_WAIT(); __syncthreads();
}

constexpr int E1_Q = 0, E1_K = 17408, E1_M = 34816, E1_TMP = 51200, E1_AQ = 55296, E1_KDT = 64512, E1_UW = 82944, E1_G = 119808, E1_B = 120064, E1_SS = 120320;
constexpr int E1_P = 136, E1_P2 = 72;
DI void dn_e1_unit(const Args& a, LAS unsigned char* lds, int unit, int tid, int wave, int lane) {
    asm volatile("" : "+v"(tid), "+v"(lane));
    const bf16* Z = (const bf16*)(a.ws + WS_Z); const float* AB = (const float*)(a.ws + WS_AB);
    const int c = unit % NCH, bh = unit / NCH, h = bh & 15, b = bh >> 4;
    LAS bf16* Qs = (LAS bf16*)(lds + E1_Q); LAS bf16* Ks = (LAS bf16*)(lds + E1_K); LAS float* Ms = (LAS float*)(lds + E1_M); LAS float* Tmp = (LAS float*)(lds + E1_TMP);
    LAS bf16* Aq = (LAS bf16*)(lds + E1_AQ); LAS bf16* KdT = (LAS bf16*)(lds + E1_KDT); LAS bf16* UWt = (LAS bf16*)(lds + E1_UW);
    LAS float* Gs = (LAS float*)(lds + E1_G); LAS float* Bs = (LAS float*)(lds + E1_B); LAS float* SS = (LAS float*)(lds + E1_SS);
    const int r = lane & 15, q = lane >> 4;
    float y[8][8]; int which = 0, cc = 0, tb = 0;
    LAS float* PS = (LAS float*)(lds + E1_UW);
    if (tid < 384) { const int ch = tid >> 3; tb = tid & 7; which = ch >> 4; cc = (ch & 15) * 8; const int col = which * QB + h * BHD + cc;
        float w[4][8];
#pragma unroll
        for (int j = 0; j < 4; ++j) { const f32x4 w0 = *(const GAS f32x4*)(a.in[I_CONVW] + (size_t)j * CONVD + col), w1 = *(const GAS f32x4*)(a.in[I_CONVW] + (size_t)j * CONVD + col + 4);
            w[j][0] = w0.x; w[j][1] = w0.y; w[j][2] = w0.z; w[j][3] = w0.w; w[j][4] = w1.x; w[j][5] = w1.y; w[j][6] = w1.z; w[j][7] = w1.w; }
        v4u xv[11];
#pragma unroll
        for (int k = 0; k < 11; ++k) { const int p = 64 * c + 8 * tb + k - 3 - 48; v4u v = {0u, 0u, 0u, 0u};
            if (p >= 0) { const int row = p < NMETA ? META0 + p : b * PSEQ + p - NMETA; v = *(const GAS v4u*)(Z + (size_t)row * ZLD + ZC_QKVB + col); }
            xv[k] = v; }
#define XE(k, e) (((e) & 1) ? bfhi(xv[k][(e) >> 1]) : bflo(xv[k][(e) >> 1]))
#pragma unroll
        for (int t = 0; t < 8; ++t) { float ss = 0.f;
#pragma unroll
            for (int e = 0; e < 8; ++e) { const float v = XE(t, e) * w[0][e] + XE(t + 1, e) * w[1][e] + XE(t + 2, e) * w[2][e] + XE(t + 3, e) * w[3][e]; const float sv = siluf(v); y[t][e] = sv; ss += sv * sv; }
#undef XE
            if (which < 2) PS[(which * 64 + 8 * tb + t) * 16 + (ch & 15)] = ss; }
    } else if (wave == 7) { const int i = lane; const int p = 64 * c + i - 48; float g = 0.f, be = 0.f;
        if (p >= 0) { const int row = p < NMETA ? META0 + p : b * PSEQ + p - NMETA; const float braw = AB[(size_t)row * 32 + h], araw = AB[(size_t)row * 32 + 16 + h];
            g = -__expf(a.in[I_ALOG][h]) * softplusf_(araw + a.in[I_DTB][h]); be = sigm(braw); }
#pragma unroll
        for (int o = 1; o < 64; o <<= 1) { const float t = __shfl_up(g, o); if (lane >= o) g += t; }
        Gs[i] = g; Bs[i] = be; }
    LDS_WAIT(); __syncthreads();
    if (tid < 128) { float t = 0.f;
#pragma unroll
        for (int k = 0; k < 16; ++k) t += PS[tid * 16 + k];
        SS[tid] = t; }
    LDS_WAIT(); __syncthreads();
    if (tid < 384) {
        float sc[8];
#pragma unroll
        for (int t = 0; t < 8; ++t) { const int i = 8 * tb + t; sc[t] = which < 2 ? (1.0f / sqrtf(SS[which * 64 + i] + EPS)) * (which == 0 ? 0.08838834764831845f : 1.0f) : 1.0f; }
        if (which < 2) { LAS bf16* dst = which == 0 ? Qs : Ks;
#pragma unroll
            for (int t = 0; t < 8; ++t) { const int i = 8 * tb + t;
                v4u o; o.x = pk2(y[t][0] * sc[t], y[t][1] * sc[t]); o.y = pk2(y[t][2] * sc[t], y[t][3] * sc[t]); o.z = pk2(y[t][4] * sc[t], y[t][5] * sc[t]); o.w = pk2(y[t][6] * sc[t], y[t][7] * sc[t]);
                *(LAS v4u*)(dst + i * E1_P + cc) = o; } }
        if (which >= 1) { float f[8];
#pragma unroll
            for (int t = 0; t < 8; ++t) { const int i = 8 * tb + t; f[t] = which == 1 ? Bs[i] * __expf(Gs[i]) * sc[t] : Bs[i]; }
            LAS bf16* dst = UWt + ((which == 1 ? 128 : 0) + cc) * E1_P2 + 8 * tb;
#pragma unroll
            for (int e = 0; e < 8; ++e) { v4u o; o.x = pk2(y[0][e] * f[0], y[1][e] * f[1]); o.y = pk2(y[2][e] * f[2], y[3][e] * f[3]); o.z = pk2(y[4][e] * f[4], y[5][e] * f[5]); o.w = pk2(y[6][e] * f[6], y[7][e] * f[7]);
                *(LAS v4u*)(dst + e * E1_P2) = o; } } }
    LDS_WAIT(); __syncthreads();
    { const int mb = wave >> 1;
#pragma unroll
      for (int nn = 0; nn < 2; ++nn) { const int nb = 2 * (wave & 1) + nn;
        const f32x4 kk = mm_lds<4>(Ks, E1_P, 16 * mb, Ks, E1_P, 16 * nb, r, q);
#pragma unroll
        for (int e = 0; e < 4; ++e) { const int i = 16 * mb + 4 * q + e, j = 16 * nb + r; Ms[i * 64 + j] = j < i ? Bs[i] * kk[e] * __expf(Gs[i] - Gs[j]) : 0.f; }
        const f32x4 qk = mm_lds<4>(Ks, E1_P, 16 * nb, Qs, E1_P, 16 * mb, r, q);
        const int i = 16 * mb + r; float v[4];
#pragma unroll
        for (int e = 0; e < 4; ++e) { const int j = 16 * nb + 4 * q + e; v[e] = j <= i ? qk[e] * __expf(Gs[i] - Gs[j]) : 0.f; }
        v2u w; w.x = pk2(v[0], v[1]); w.y = pk2(v[2], v[3]); *(LAS v2u*)(Aq + i * E1_P2 + 16 * nb + 4 * q) = w; } }
    { const int dk = tid & 127, qtr = tid >> 7; const float gl = Gs[63];
#pragma unroll
      for (int i8 = 0; i8 < 2; ++i8) { float v[8];
#pragma unroll
          for (int e = 0; e < 8; ++e) { const int i = 16 * qtr + 8 * i8 + e; v[e] = bf2f(Ks[i * E1_P + dk]) * __expf(gl - Gs[i]); }
          v4u o; o.x = pk2(v[0], v[1]); o.y = pk2(v[2], v[3]); o.z = pk2(v[4], v[5]); o.w = pk2(v[6], v[7]); *(LAS v4u*)(KdT + dk * E1_P2 + 16 * qtr + 8 * i8) = o; } }
    LDS_WAIT(); __syncthreads();
    if (wave == 0) { const int blk = lane >> 4, col = lane & 15; LAS float* Mb = Ms + (16 * blk) * 64 + 16 * blk; float x[16];
#pragma unroll
        for (int i = 0; i < 16; ++i) { float acc = (i == col) ? 1.f : 0.f;
#pragma unroll
            for (int j = 0; j < i; ++j) acc -= Mb[i * 64 + j] * x[j];
            x[i] = acc; }
        LDS_WAIT(); asm volatile("" ::: "memory");
#pragma unroll
        for (int i = 0; i < 16; ++i) Mb[i * 64 + col] = x[i]; }
    LDS_WAIT(); __syncthreads();
    {
        const int g2 = tid >> 8, i = (tid >> 4) & 15, j = tid & 15; const int r0 = 16 + 32 * g2, c0 = 32 * g2; float p = 0.f;
#pragma unroll
        for (int k = 0; k < 16; ++k) p += Ms[(r0 + i) * 64 + c0 + k] * Ms[(c0 + k) * 64 + c0 + j];
        Tmp[g2 * 256 + i * 16 + j] = p;
        LDS_WAIT(); __syncthreads();
        float t = 0.f;
#pragma unroll
        for (int k = 0; k < 16; ++k) t += Ms[(r0 + i) * 64 + r0 + k] * Tmp[g2 * 256 + k * 16 + j];
        Ms[(r0 + i) * 64 + c0 + j] = -t; }
    LDS_WAIT(); __syncthreads();
    {
        const int i = tid >> 4, j0 = (tid & 15) * 2; float p0 = 0.f, p1 = 0.f;
#pragma unroll 8
        for (int k = 0; k < 32; ++k) { const float m = Ms[(32 + i) * 64 + k]; p0 += m * Ms[k * 64 + j0]; p1 += m * Ms[k * 64 + j0 + 1]; }
        LDS_WAIT(); __syncthreads();
        Tmp[i * 32 + j0] = p0; Tmp[i * 32 + j0 + 1] = p1;
        LDS_WAIT(); __syncthreads();
        float t0 = 0.f, t1 = 0.f;
#pragma unroll 8
        for (int k = 0; k < 32; ++k) { const float m = Ms[(32 + i) * 64 + 32 + k]; t0 += m * Tmp[k * 32 + j0]; t1 += m * Tmp[k * 32 + j0 + 1]; }
        Ms[(32 + i) * 64 + j0] = -t0; Ms[(32 + i) * 64 + j0 + 1] = -t1; }
    LDS_WAIT(); __syncthreads();
    {
        bf16x8 tf[4][2];
#pragma unroll
        for (int mb = 0; mb < 4; ++mb)
#pragma unroll
            for (int ks = 0; ks < 2; ++ks) { const LAS float* tp = Ms + (16 * mb + r) * 64 + 32 * ks + 8 * q; const f32x4 t0 = *(const LAS f32x4*)tp, t1 = *(const LAS f32x4*)(tp + 4);
                tf[mb][ks] = pack8(t0.x, t0.y, t0.z, t0.w, t1.x, t1.y, t1.z, t1.w); }
#pragma unroll
        for (int nn = 0; nn < 2; ++nn) { const int nb = 2 * wave + nn; LAS bf16* rowp = UWt + (16 * nb + r) * E1_P2;
            const bf16x8 y0 = *(const LAS bf16x8*)(rowp + 8 * q), y1 = *(const LAS bf16x8*)(rowp + 32 + 8 * q);
            f32x4 d[4];
#pragma unroll
            for (int mb = 0; mb < 4; ++mb) { f32x4 acc = {0.f, 0.f, 0.f, 0.f}; acc = MFMA16(tf[mb][0], y0, acc); acc = MFMA16(tf[mb][1], y1, acc); d[mb] = acc; }
            LDS_WAIT(); asm volatile("" ::: "memory");
#pragma unroll
            for (int mb = 0; mb < 4; ++mb) { v2u w; w.x = pk2(d[mb][0], d[mb][1]); w.y = pk2(d[mb][2], d[mb][3]); *(LAS v2u*)(rowp + 16 * mb + 4 * q) = w; } } }
    LDS_WAIT(); __syncthreads();
#ifndef DBG_NOSTEP3
    unsigned char* ws = a.ws;
    {
        const int mb = wave >> 1, i = 16 * mb + r; const float eg = __expf(Gs[i]);
#pragma unroll
        for (int n8 = 0; n8 < 8; ++n8) { const int nb = 8 * (wave & 1) + n8;
            const f32x4 p = mm_lds<2>(UWt, E1_P2, 16 * nb, Aq, E1_P2, 16 * mb, r, q);
            if (nb < 8) { v2u w; w.x = pk2(p[0], p[1]); w.y = pk2(p[2], p[3]); *(GAS v2u*)((bf16*)(ws + DN_OL) + (size_t)unit * 8192 + i * 128 + 16 * nb + 4 * q) = w; }
            else { const int dk0 = 16 * (nb - 8) + 4 * q; const v2u qv = *(const LAS v2u*)(Qs + i * E1_P + dk0);
                v2u w; w.x = pk2(bflo(qv.x) * eg - p[0], bfhi(qv.x) * eg - p[1]); w.y = pk2(bflo(qv.y) * eg - p[2], bfhi(qv.y) * eg - p[3]);
                *(GAS v2u*)((bf16*)(ws + DN_QE) + (size_t)unit * 8192 + i * 128 + dk0) = w; } }
    }
    {
        const int mb = wave; const float gl = __expf(Gs[63]);
#pragma unroll
        for (int nb = 0; nb < 8; ++nb) {
            const f32x4 p = mm_lds<2>(KdT, E1_P2, 16 * mb, UWt, E1_P2, 16 * nb, r, q);
            v2u w; w.x = pk2(p[0], p[1]); w.y = pk2(p[2], p[3]);
            *(GAS v2u*)(ws + DN_BC + (size_t)unit * 32768 + ((size_t)((nb * 4 + (mb >> 1)) * 64 + lane) * 2 + (mb & 1)) * 8) = w; }
#pragma unroll
        for (int nb = 0; nb < 8; ++nb) {
            const f32x4 p = mm_lds<2>(UWt, E1_P2, 128 + 16 * nb, KdT, E1_P2, 16 * mb, r, q);
            float v[4];
#pragma unroll
            for (int e = 0; e < 4; ++e) v[e] = ((16 * mb + r) == (16 * nb + 4 * q + e) ? gl : 0.f) - p[e];
            v2u w; w.x = pk2(v[0], v[1]); w.y = pk2(v[2], v[3]);
            *(GAS v2u*)(ws + DN_AC + (size_t)unit * 32768 + ((size_t)((mb * 4 + (nb >> 1)) * 64 + lane) * 2 + (nb & 1)) * 8) = w; }
    }
#endif
    LDS_WAIT(); __syncthreads();
}

DI void scan_glds16(const void* gsrc, unsigned lds_dst) { unsigned keep;
    asm volatile("s_mov_b32 %0, m0\n\ts_mov_b32 m0, %2\n\ts_nop 0\n\tglobal_load_lds_dwordx4 %1, off\n\ts_mov_b32 m0, %0" : "=&s"(keep) : "v"(gsrc), "s"(lds_dst) : "memory"); }
DI void dn_scan(const Args& a, LAS unsigned char* lds, int bh, int tid, int wave, int lane) {
    unsigned char* ws = a.ws; const int r = lane & 15, q = lane >> 4, s = wave;
    f32x4 S[8];
#pragma unroll
    for (int rb = 0; rb < 8; ++rb) S[rb] = (f32x4){0.f, 0.f, 0.f, 0.f};
    const unsigned char* ac = ws + DN_AC + (size_t)(bh * NCH) * 32768 + (size_t)wave * 4096 + lane * 16;
    const unsigned char* bc = ws + DN_BC + (size_t)(bh * NCH) * 32768 + (size_t)(s * 4 * 64 + lane) * 16;
#define SCAN_LOAD_A(cc) do { const int c_ = (cc) < NCH ? (cc) : NCH - 1; const unsigned char* src_ = ac + (size_t)c_ * 32768; \
        _Pragma("unroll") for (int p = 0; p < 4; ++p) __builtin_amdgcn_global_load_lds((const unsigned*)(src_ + p * 1024), (LAS unsigned*)(lds + wave * 4096 + ((cc) & 3) * 32768 + p * 1024), 16, 0, 0); } while (0)
#define SCAN_LOAD_B(Bx, cc) do { const int c_ = (cc) < NCH ? (cc) : NCH - 1; const unsigned char* src_ = bc + (size_t)c_ * 32768; \
        _Pragma("unroll") for (int p = 0; p < 4; ++p) Bx[p] = *(const GAS v4u*)(src_ + p * 1024); } while (0)
#define SCAN_WAIT_B(Bx, N) asm volatile("s_waitcnt vmcnt(" #N ")" : "+v"(Bx[0]), "+v"(Bx[1]), "+v"(Bx[2]), "+v"(Bx[3]) :: "memory")
    const unsigned ring_s = (unsigned)__builtin_amdgcn_readfirstlane((int)(unsigned)(size_t)(lds + wave * 4096));
    v4u B0[4], B1[4];
    SCAN_LOAD_B(B0, 0); SCAN_LOAD_B(B1, 1); asm volatile("" ::: "memory"); SCAN_LOAD_A(0); SCAN_LOAD_A(1); SCAN_LOAD_A(2);
    asm volatile("s_waitcnt vmcnt(4)" : "+v"(B0[0]), "+v"(B0[1]), "+v"(B0[2]), "+v"(B0[3]), "+v"(B1[0]), "+v"(B1[1]), "+v"(B1[2]), "+v"(B1[3]) :: "memory");
#define SCAN_STEP(c, Bx) do { \
        __builtin_amdgcn_s_barrier(); asm volatile("" ::: "memory"); \
        SCAN_LOAD_A((c) + 3); \
        { bf16* st_ = (bf16*)(ws + DN_ST) + (size_t)(bh * NCH + (c)) * 16384 + (16 * s + r) * 128 + 4 * q; \
          _Pragma("unroll") for (int rb = 0; rb < 8; ++rb) { v2u w_; w_.x = pk2(S[rb][0], S[rb][1]); w_.y = pk2(S[rb][2], S[rb][3]); *(GAS v2u*)(st_ + 16 * rb) = w_; } } \
        bf16x8 Sf_[4]; \
        _Pragma("unroll") for (int j = 0; j < 4; ++j) Sf_[j] = pack8(S[2 * j][0], S[2 * j][1], S[2 * j][2], S[2 * j][3], S[2 * j + 1][0], S[2 * j + 1][1], S[2 * j + 1][2], S[2 * j + 1][3]); \
        const LAS unsigned char* slot_ = lds + ((c) & 3) * 32768 + lane * 16; \
        _Pragma("unroll") for (int rb = 0; rb < 8; ++rb) { f32x4 acc_ = {0.f, 0.f, 0.f, 0.f}; \
            _Pragma("unroll") for (int j = 0; j < 4; ++j) { const bf16x8 af_ = *(const LAS bf16x8*)(slot_ + (rb * 4 + j) * 1024); acc_ = MFMA16(af_, Sf_[j], acc_); } \
            S[rb] = acc_; } \
        SCAN_WAIT_B(Bx, 28);     \
        _Pragma("unroll") for (int p = 0; p < 4; ++p) { \
            S[2 * p][0] += bflo(Bx[p].x); S[2 * p][1] += bfhi(Bx[p].x); S[2 * p][2] += bflo(Bx[p].y); S[2 * p][3] += bfhi(Bx[p].y); \
            S[2 * p + 1][0] += bflo(Bx[p].z); S[2 * p + 1][1] += bfhi(Bx[p].z); S[2 * p + 1][2] += bflo(Bx[p].w); S[2 * p + 1][3] += bfhi(Bx[p].w); } \
        SCAN_LOAD_B(Bx, (c) + 2); \
        asm volatile("s_waitcnt vmcnt(32)" ::: "memory");     \
    } while (0)
    for (int c2 = 0; c2 < NCH - 1; c2 += 2) { SCAN_STEP(c2, B0); SCAN_STEP(c2 + 1, B1); }
    SCAN_STEP(NCH - 1, B0);
#undef SCAN_STEP
#undef SCAN_LOAD_A
#undef SCAN_LOAD_B
#undef SCAN_WAIT_B
    float* dp = a.out + O_DP + (size_t)bh * BHD * BHD + 16 * s + r;
#pragma unroll
    for (int rb = 0; rb < 8; ++rb)
#pragma unroll
        for (int e = 0; e < 4; ++e) dp[(size_t)(16 * rb + 4 * q + e) * BHD] = S[rb][e];
    asm volatile("s_waitcnt vmcnt(0)" ::: "memory"); __syncthreads();
}

constexpr int N_E2_ITEMS = PB * BH * 64 * 4;
DI void dn_e2_item(const Args& a, int item, int lane) {
    unsigned char* ws = a.ws; const bf16* Z = (const bf16*)(ws + WS_Z); bf16* OB = (bf16*)(ws + WS_OB);
    const int r = lane & 15, q = lane >> 4; const int mb = item & 3, cu = item >> 2; const int c = (cu & 63) + 1, bh = cu >> 6, h = bh & 15, b = bh >> 4; const int unit = bh * NCH + c;
    const bf16* qe = (const bf16*)(ws + DN_QE) + (size_t)unit * 8192 + (16 * mb + r) * 128 + 8 * q;
    bf16x8 qf[4];
#pragma unroll
    for (int ks = 0; ks < 4; ++ks) qf[ks] = __builtin_bit_cast(bf16x8, *(const GAS v4u*)(qe + 32 * ks));
    const bf16* stp = (const bf16*)(ws + DN_ST) + (size_t)unit * 16384 + r * 128 + 8 * q;
    const bf16* olp = (const bf16*)(ws + DN_OL) + (size_t)unit * 8192 + (16 * mb + r) * 128 + 4 * q;
    f32x4 o[8]; float ss = 0.f;
#pragma unroll
    for (int nb = 0; nb < 8; ++nb) { f32x4 acc = {0.f, 0.f, 0.f, 0.f};
#pragma unroll
        for (int ks = 0; ks < 4; ++ks) { const bf16x8 sf = __builtin_bit_cast(bf16x8, *(const GAS v4u*)(stp + (size_t)nb * 16 * 128 + 32 * ks)); acc = MFMA16(sf, qf[ks], acc); }
        const v2u ol = *(const GAS v2u*)(olp + 16 * nb); acc[0] += bflo(ol.x); acc[1] += bfhi(ol.x); acc[2] += bflo(ol.y); acc[3] += bfhi(ol.y);
        o[nb] = acc; ss += (acc[0] * acc[0] + acc[1] * acc[1]) + (acc[2] * acc[2] + acc[3] * acc[3]); }
    ss += __shfl_xor(ss, 16); ss += __shfl_xor(ss, 32);
    const float rstd = 1.0f / sqrtf(ss * (1.0f / 128.0f) + EPS);
    const int row = b * PSEQ + 64 * (c - 1) + 16 * mb + r;
    const bf16* zp = Z + (size_t)row * ZLD + ZC_ZB + h * BHD + 4 * q; bf16* op = OB + (size_t)row * QB + h * BHD + 4 * q; const float* dn = a.in[I_DNORM] + 4 * q;
#pragma unroll
    for (int nb = 0; nb < 8; ++nb) { const v2u zv = *(const GAS v2u*)(zp + 16 * nb); const f32x4 g = *(const GAS f32x4*)(dn + 16 * nb);
        v2u w; w.x = pk2(o[nb][0] * rstd * g.x * siluf(bflo(zv.x)), o[nb][1] * rstd * g.y * siluf(bfhi(zv.x))); w.y = pk2(o[nb][2] * rstd * g.z * siluf(bflo(zv.y)), o[nb][3] * rstd * g.w * siluf(bfhi(zv.y)));
        *(GAS v2u*)(op + 16 * nb) = w; }
}

DI float* out_row(const Args& a, int m) { return a.out + (m < MP ? O_YP + (size_t)m * DM : O_YS + (size_t)(m - MP) * DM); }
DI void part_row_sum(const Args& a, int m, int lane, f32x4 (&v)[16], float& ssq) {
    const GAS f32x4* pr = (const GAS f32x4*)((const float*)(a.ws + WS_PART) + (size_t)(m - MFULL) * DM) + lane;
#pragma unroll
    for (int j = 0; j < 16; ++j) v[j] = pr[64 * j];
#pragma unroll 1
    for (int k = 1; k < NSPLIT; ++k) { const GAS f32x4* pk = pr + (size_t)k * (MTAIL * DM / 4);
#pragma unroll
        for (int j = 0; j < 16; ++j) { const f32x4 u = pk[64 * j]; v[j].x += u.x; v[j].y += u.y; v[j].z += u.z; v[j].w += u.w; } }
    float s = 0.f;
#pragma unroll
    for (int j = 0; j < 16; ++j) s += (v[j].x * v[j].x + v[j].y * v[j].y) + (v[j].z * v[j].z + v[j].w * v[j].w);
    ssq = wave_sum(s);
}
DI void norm1_row_tail(const Args& a, int m, int lane) {
    f32x4 v[16]; float ssq; part_row_sum(a, m, lane, v, ssq); const float rstd1 = 1.0f / sqrtf(ssq * (1.0f / DM) + EPS);
    const GAS f32x4* hr = (const GAS f32x4*)h_row(a, m) + lane; const GAS f32x4* wp = (const GAS f32x4*)a.in[I_NMIXPOST] + lane; const GAS f32x4* wm = (const GAS f32x4*)a.in[I_NMLPPRE] + lane;
    GAS f32x4* orow = (GAS f32x4*)out_row(a, m) + lane; GAS v2u* xn = (GAS v2u*)((bf16*)(a.ws + WS_XN) + (size_t)m * DM) + lane; float s = 0.f;
#pragma unroll
    for (int j = 0; j < 16; ++j) { const f32x4 hh = hr[64 * j], rw = v[j], g = wp[64 * j]; f32x4 t; t.x = hh.x + rw.x * rstd1 * g.x; t.y = hh.y + rw.y * rstd1 * g.y; t.z = hh.z + rw.z * rstd1 * g.z; t.w = hh.w + rw.w * rstd1 * g.w;
        v[j] = t; orow[64 * j] = t; s += (t.x * t.x + t.y * t.y) + (t.z * t.z + t.w * t.w); }
    const float rstd2 = 1.0f / sqrtf(wave_sum(s) * (1.0f / DM) + EPS);
#pragma unroll
    for (int j = 0; j < 16; ++j) { const f32x4 g = wm[64 * j]; v2u o; o.x = pk2(v[j].x * rstd2 * g.x, v[j].y * rstd2 * g.y); o.y = pk2(v[j].z * rstd2 * g.z, v[j].w * rstd2 * g.w); xn[64 * j] = o; }
}
DI void norm2_row_tail(const Args& a, int m, int lane) {
    f32x4 v[16]; float ssq; part_row_sum(a, m, lane, v, ssq); const float rstd = 1.0f / sqrtf(ssq * (1.0f / DM) + EPS);
    const GAS f32x4* wp = (const GAS f32x4*)a.in[I_NMLPPOST] + lane; GAS f32x4* orow = (GAS f32x4*)out_row(a, m) + lane;
#pragma unroll
    for (int j = 0; j < 16; ++j) { const f32x4 hh = orow[64 * j], rw = v[j], g = wp[64 * j]; f32x4 t; t.x = hh.x + rw.x * rstd * g.x; t.y = hh.y + rw.y * rstd * g.y; t.z = hh.z + rw.z * rstd * g.z; t.w = hh.w + rw.w * rstd * g.w; orow[64 * j] = t; }
}
DI void norm1_row(const Args& a, int m, int lane) {
    if (m >= MFULL) { norm1_row_tail(a, m, lane); return; }
    const float* SQ = (const float*)(a.ws + WS_SQ1) + (size_t)m * 64; const float rstd1 = 1.0f / sqrtf(wave_sum(SQ[lane]) * (1.0f / DM) + EPS);
    const GAS f32x4* hr = (const GAS f32x4*)h_row(a, m) + lane; const GAS f32x4* rr = (const GAS f32x4*)((const float*)(a.ws + WS_RAW) + (size_t)m * DM) + lane;
    const GAS f32x4* wp = (const GAS f32x4*)a.in[I_NMIXPOST] + lane; const GAS f32x4* wm = (const GAS f32x4*)a.in[I_NMLPPRE] + lane;
    GAS f32x4* orow = (GAS f32x4*)out_row(a, m) + lane; GAS v2u* xn = (GAS v2u*)((bf16*)(a.ws + WS_XN) + (size_t)m * DM) + lane;
    f32x4 v[16]; float s = 0.f;
#pragma unroll
    for (int j = 0; j < 16; ++j) { const f32x4 hh = hr[64 * j], rw = rr[64 * j], g = wp[64 * j]; f32x4 t; t.x = hh.x + rw.x * rstd1 * g.x; t.y = hh.y + rw.y * rstd1 * g.y; t.z = hh.z + rw.z * rstd1 * g.z; t.w = hh.w + rw.w * rstd1 * g.w;
        v[j] = t; orow[64 * j] = t; s += (t.x * t.x + t.y * t.y) + (t.z * t.z + t.w * t.w); }
    const float rstd2 = 1.0f / sqrtf(wave_sum(s) * (1.0f / DM) + EPS);
#pragma unroll
    for (int j = 0; j < 16; ++j) { const f32x4 g = wm[64 * j]; v2u o; o.x = pk2(v[j].x * rstd2 * g.x, v[j].y * rstd2 * g.y); o.y = pk2(v[j].z * rstd2 * g.z, v[j].w * rstd2 * g.w); xn[64 * j] = o; }
}
DI void norm2_row(const Args& a, int m, int lane) {
    if (m >= MFULL) { norm2_row_tail(a, m, lane); return; }
    const float* SQ = (const float*)(a.ws + WS_SQ2) + (size_t)m * 64; const float rstd = 1.0f / sqrtf(wave_sum(SQ[lane]) * (1.0f / DM) + EPS);
    const GAS f32x4* rr = (const GAS f32x4*)((const float*)(a.ws + WS_RAW) + (size_t)m * DM) + lane; const GAS f32x4* wp = (const GAS f32x4*)a.in[I_NMLPPOST] + lane; GAS f32x4* orow = (GAS f32x4*)out_row(a, m) + lane;
#pragma unroll
    for (int j = 0; j < 16; ++j) { const f32x4 hh = orow[64 * j], rw = rr[64 * j], g = wp[64 * j]; f32x4 t; t.x = hh.x + rw.x * rstd * g.x; t.y = hh.y + rw.y * rstd * g.y; t.z = hh.z + rw.z * rstd * g.z; t.w = hh.w + rw.w * rstd * g.w; orow[64 * j] = t; }
}

#ifndef MK_ONE_LAUNCH
#define MK_ONE_LAUNCH 1
#endif
constexpr int NPHASE = 11;
constexpr int NSCAN = PB * BH;
constexpr int N_MIX_ITEMS = 4096;
__global__ void __launch_bounds__(NTHR, 2) fwd(Args args) {
    extern __shared__ __attribute__((aligned(16))) unsigned char lds_raw[];
    LAS unsigned char* lds = (LAS unsigned char*)lds_raw;
    const int tid = threadIdx.x, lane = tid & 63, wave = __builtin_amdgcn_readfirstlane(tid >> 6);
    const int lo = args.ph_lo, hi = args.ph_hi; const int G = gridDim.x, bid = blockIdx.x;
    volatile LAS unsigned* MISC = (volatile LAS unsigned*)(lds + MISC_OFF);
    for (int u = tid; u < (LDS_BYTES - LDSCTL_OFF) / 4; u += NTHR) ((LAS unsigned*)(lds + LDSCTL_OFF))[u] = 0u;
    __syncthreads();
#if MK_ONE_LAUNCH
    XcdBarrier bar = xcd_barrier_post((unsigned*)(args.ws + WS_CTL) + CW_BAR, MISC + 8);
#define GRID_BAR() xcd_barrier(bar)
#else
    (void)MISC;
#define GRID_BAR() do {} while (0)
#endif
#ifndef PHASE_MASK
#define PHASE_MASK 0x7ff
#endif
#define IN(k) ((((PHASE_MASK) >> (k)) & 1) && lo <= (k) && (k) < hi)
#define BOTH(k) (IN(k) && IN((k) + 1))
    if (IN(0)) { p0_prologue(args, lds, wave, lane); if (BOTH(0)) GRID_BAR(); }
    if (IN(1)) {
        pg8::Gemm g{(const bf16*)(args.ws + WS_XN), (const bf16*)(args.ws + WS_WIN), MPAD, NINP, DM, DM, DM}; pg8::StaticOrder S; S.init(MPAD, NINP, G, bid);
        pg8::EpiZ E{(bf16*)(args.ws + WS_Z), ZLD, MVALID, ZLD, (float*)(args.ws + WS_AB)};
        pg8::gemm_phase<pg8::EpiZ, pg8::StaticOrder, true, true>(lds + RING_OFF, g, S, E);
        if (BOTH(1)) GRID_BAR();
    }
    if (IN(2)) {
        p2_state_outputs(args);
        for (int u = bid; u < NUNIT_DN; u += G) dn_e1_unit(args, lds, u, tid, wave, lane);
        if (BOTH(2)) GRID_BAR();
    }
    if (IN(3)) {
        const bool has_workers = G > NSCAN;
        if (bid < NSCAN || !has_workers) { for (int bh = bid; bh < NSCAN; bh += G) dn_scan(args, lds, bh, tid, wave, lane); }
        if (bid >= NSCAN || !has_workers) { const int W = has_workers ? G - NSCAN : G, w = has_workers ? bid - NSCAN : bid;
            for (int i = w; i < N_MIX_ITEMS; i += W) { const int type = (i + (i >> 5)) & 3, idx = i >> 2;
                if (type == 0) attn_prompt_unit(args, lds, idx, tid, wave, lane);
                else if (type == 1) attn_sample_unit(args, lds, idx, tid, wave, lane);
                else dn_sample_unit(args, lds, 2 * idx + (type - 2), tid, wave, lane); } }
        if (BOTH(3)) GRID_BAR();
    }
    if (IN(4)) {
        for (int it = bid * NWAVES + wave; it < N_E2_ITEMS; it += G * NWAVES) dn_e2_item(args, it, lane);
        if (BOTH(4)) GRID_BAR();
    }
    if (IN(5)) {
        { pg8::Gemm g{(const bf16*)(args.ws + WS_OA), (const bf16*)(args.ws + WS_WA), MM, DM, QB, QB, QB}; pg8::StaticOrder S; S.init(MM, DM, G, bid);
          pg8::EpiGateF32 E{(float*)(args.ws + WS_RAW), DM, (const bf16*)(args.ws + WS_Z) + ZC_GA, ZLD};
          pg8::gemm_phase<pg8::EpiGateF32, pg8::StaticOrder, true, true>(lds + RING_OFF, g, S, E); }
        __builtin_amdgcn_fence(__ATOMIC_ACQUIRE, "agent"); asm volatile("s_waitcnt vmcnt(0)" ::: "memory"); __syncthreads();
        { pg8::Gemm g{(const bf16*)(args.ws + WS_OB), (const bf16*)(args.ws + WS_WB), MM, DM, QB, QB, QB}; pg8::StaticOrder S; S.init(MM, DM, G, bid);
          pg8::EpiGateAddBf16 E{(bf16*)(args.ws + WS_MERGED), (const float*)(args.ws + WS_RAW), DM, (const bf16*)(args.ws + WS_Z) + ZC_GB, ZLD};
          pg8::gemm_phase<pg8::EpiGateAddBf16, pg8::StaticOrder, true, true>(lds + RING_OFF, g, S, E); }
        if (BOTH(5)) GRID_BAR();
    }
    if (IN(6)) {
        { pg8::Gemm g{(const bf16*)(args.ws + WS_MERGED), (const bf16*)(args.ws + WS_WOUT), MFULL, DM, DM, DM, DM}; pg8::StaticOrder S; S.init(MFULL, DM, G, bid);
          pg8::EpiRawSq E{(float*)(args.ws + WS_RAW), DM, (float*)(args.ws + WS_SQ1), 64};
          pg8::gemm_phase<pg8::EpiRawSq, pg8::StaticOrder, true, true>(lds + RING_OFF, g, S, E); }
        { pg8::Gemm g{(const bf16*)(args.ws + WS_MERGED) + (size_t)MFULL * DM, (const bf16*)(args.ws + WS_WOUT), MTAIL, DM, DM / NSPLIT, DM, DM}; pg8::PieceOrder S; S.init(MTAIL, DM, NSPLIT, bid);
          pg8::EpiPart E{(float*)(args.ws + WS_PART), DM, (size_t)MTAIL * DM};
          pg8::gemm_phase<pg8::EpiPart, pg8::PieceOrder, false, true>(lds + RING_OFF, g, S, E); }
        if (BOTH(6)) GRID_BAR();
    }
    if (IN(7)) {
        for (int m = bid * NWAVES + wave; m < MM; m += G * NWAVES) norm1_row(args, m, lane);
        if (BOTH(7)) GRID_BAR();
    }
    if (IN(8)) {
        pg8::Gemm g{(const bf16*)(args.ws + WS_XN), (const bf16*)(args.ws + WS_WUP), MM, DFF, DM, DM, DM}; pg8::StaticOrder S; S.init(MM, DFF, G, bid);
        pg8::EpiRelu2 E{(bf16*)(args.ws + WS_UACT), DFF};
        pg8::gemm_phase<pg8::EpiRelu2, pg8::StaticOrder, true, true>(lds + RING_OFF, g, S, E);
        if (BOTH(8)) GRID_BAR();
    }
    if (IN(9)) {
        { pg8::Gemm g{(const bf16*)(args.ws + WS_UACT), (const bf16*)(args.ws + WS_WDN), MFULL, DM, DFF, DFF, DFF}; pg8::StaticOrder S; S.init(MFULL, DM, G, bid);
          pg8::EpiRawSq E{(float*)(args.ws + WS_RAW), DM, (float*)(args.ws + WS_SQ2), 64};
          pg8::gemm_phase<pg8::EpiRawSq, pg8::StaticOrder, true, true>(lds + RING_OFF, g, S, E); }
        { pg8::Gemm g{(const bf16*)(args.ws + WS_UACT) + (size_t)MFULL * DFF, (const bf16*)(args.ws + WS_WDN), MTAIL, DM, DFF / NSPLIT, DFF, DFF}; pg8::PieceOrder S; S.init(MTAIL, DM, NSPLIT, bid);
          pg8::EpiPart E{(float*)(args.ws + WS_PART), DM, (size_t)MTAIL * DM};
          pg8::gemm_phase<pg8::EpiPart, pg8::PieceOrder, false, true>(lds + RING_OFF, g, S, E); }
        if (BOTH(9)) GRID_BAR();
    }
    if (IN(10)) {
        for (int m = bid * NWAVES + wave; m < MM; m += G * NWAVES) norm2_row(args, m, lane);
    }
#undef IN
#undef BOTH
}

extern "C" void kernel_launch(void* const* d_in, const int* in_sizes, int n_in, void* d_out, int out_size, void* d_ws, size_t ws_size, hipStream_t stream) {
    static int grid = 0;
    if (grid == 0) {
        if (n_in != 22 || out_size != (int)O_END || ws_size < WS_END) { fprintf(stderr, "kernel_launch: unexpected shapes n_in %d out %d ws %zu\n", n_in, out_size, ws_size); grid = -1; return; }
        int dev = 0, cus = 0, per_cu = 0;
        if (hipGetDevice(&dev) != hipSuccess || hipDeviceGetAttribute(&cus, hipDeviceAttributeMultiprocessorCount, dev) != hipSuccess) { grid = -1; return; }
        if (hipFuncSetAttribute((const void*)fwd, hipFuncAttributeMaxDynamicSharedMemorySize, LDS_BYTES) != hipSuccess) { fprintf(stderr, "kernel_launch: hipFuncSetAttribute failed\n"); grid = -1; return; }
        if (hipOccupancyMaxActiveBlocksPerMultiprocessor(&per_cu, (const void*)fwd, NTHR, LDS_BYTES) != hipSuccess || per_cu < 1) { fprintf(stderr, "kernel_launch: occupancy query reports %d\n", per_cu); }
        (void)hipGetLastError();
        grid = cus;
    }
    if (grid < 0) return;
    (void)hipMemsetAsync((char*)d_ws + WS_CTL, 0, CTL_ZERO_BYTES, stream);
    Args a{};
    for (int i = 0; i < 22; ++i) a.in[i] = (const float*)d_in[i];
    a.out = (float*)d_out; a.ws = (unsigned char*)d_ws;
#if MK_ONE_LAUNCH
    a.ph_lo = 0; a.ph_hi = NPHASE; hipLaunchKernelGGL(fwd, dim3(grid), dim3(NTHR), LDS_BYTES, stream, a);
#else
    for (int p = 0; p < NPHASE; ++p) { a.ph_lo = p; a.ph_hi = p + 1; hipLaunchKernelGGL(fwd, dim3(grid), dim3(NTHR), LDS_BYTES, stream, a); }
#endif
}
```
